# Optimizing an MI355X kernel written in HIP

```python
import jax, jax.numpy as jnp
from jax import lax
import numpy as np

D_MODEL = 1024
BATCH = 4
SEQ = 4096
DEPTH = 1

GRID_W = 64
EPS = 1e-6
GLA_HEADS = 4
GLA_DK = D_MODEL // (2 * GLA_HEADS)
GLA_DV = D_MODEL // GLA_HEADS
GLA_QK = GLA_HEADS * GLA_DK
GLA_V = GLA_HEADS * GLA_DV
GLA_RANK = 16
GLA_GATE_NORM = 16.0
GLA_CHUNK = 64
ATT_HD = 128
ATT_HEADS = D_MODEL // ATT_HD
ATT_KV_HEADS = 2
ATT_Q = ATT_HEADS * ATT_HD
ATT_KV = ATT_KV_HEADS * ATT_HD
ATT_BLOCK = 128
ROPE_THETA = 10000.0
ROPE_AXIS_DIM = ATT_HD // 2
D_FF = -(-8 * D_MODEL // (3 * 256)) * 256
IN_SPLITS = (GLA_QK, GLA_QK, GLA_V, GLA_V, GLA_RANK, GLA_RANK,
             ATT_Q, ATT_KV, ATT_KV, D_MODEL, D_MODEL)
D_IN = sum(IN_SPLITS)

kernel_name = "hybrid_gla_axial_gqa_gated_encoder"


def rmsnorm(x, g):
    xf = x.astype(jnp.float32)
    y = xf * lax.rsqrt(jnp.mean(xf * xf, axis=-1, keepdims=True) + EPS)
    return (y * g.astype(jnp.float32)).astype(x.dtype)


def split_points():
    return [int(v) for v in np.cumsum(IN_SPLITS)[:-1]]


def gla_scan(q, k, v, log_a, strict):
    B, H, S, dk = q.shape
    dv = v.shape[-1]
    n = S // GLA_CHUNK

    def to_chunks(t):
        return jnp.moveaxis(t.astype(jnp.float32).reshape(B, H, n, GLA_CHUNK, t.shape[-1]), 2, 0)

    qc, kc, vc, ac = to_chunks(q), to_chunks(k), to_chunks(v), to_chunks(log_a)
    idx = jnp.arange(GLA_CHUNK)
    mask = (idx[:, None] > idx[None, :]) if strict else (idx[:, None] >= idx[None, :])

    def step(state, inp):
        qi, ki, vi, ai = inp
        cum = jnp.cumsum(ai, axis=2)
        diff = cum[:, :, :, None, :] - cum[:, :, None, :, :]
        decay = jnp.exp(jnp.where(mask[None, None, :, :, None], diff, -jnp.inf))
        scores = jnp.einsum('bhid,bhijd,bhjd->bhij', qi, decay, ki)
        o_intra = jnp.einsum('bhij,bhjv->bhiv', scores, vi)
        o_inter = jnp.einsum('bhid,bhdv->bhiv', qi * jnp.exp(cum), state)
        last = cum[:, :, -1:, :]
        k_dec = ki * jnp.exp(last - cum)
        state = state * jnp.exp(last[:, :, 0, :])[..., None] + jnp.einsum('bhjd,bhjv->bhdv', k_dec, vi)
        return state, o_intra + o_inter

    state0 = jnp.zeros((B, H, dk, dv), jnp.float32)
    _, out = lax.scan(step, state0, (qc, kc, vc, ac))
    return jnp.moveaxis(out, 0, 2).reshape(B, H, S, dv)


def axial_rope_tables(seq_len):
    rows = seq_len // GRID_W
    row = jnp.repeat(jnp.arange(rows), GRID_W).astype(jnp.float32)
    col = jnp.tile(jnp.arange(GRID_W), rows).astype(jnp.float32)
    freqs = ROPE_THETA ** (-jnp.arange(0, ROPE_AXIS_DIM, 2, dtype=jnp.float32) / ROPE_AXIS_DIM)
    ang_r = row[:, None] * freqs[None, :]
    ang_c = col[:, None] * freqs[None, :]
    return jnp.cos(ang_r), jnp.sin(ang_r), jnp.cos(ang_c), jnp.sin(ang_c)


def rope_half(x, cos, sin):
    c, s = cos[:, None, :], sin[:, None, :]
    x1, x2 = jnp.split(x, 2, axis=-1)
    return jnp.concatenate([x1 * c - x2 * s, x2 * c + x1 * s], axis=-1)


def apply_axial_rope(x, tables):
    cr, sr, cc, sc = tables
    xf = x.astype(jnp.float32)
    xr, xc = xf[..., :ROPE_AXIS_DIM], xf[..., ROPE_AXIS_DIM:]
    return jnp.concatenate([rope_half(xr, cr, sr), rope_half(xc, cc, sc)], axis=-1)


def block_attention(q, k, v):
    B, Hkv, G, S, hd = q.shape
    nb = S // ATT_BLOCK
    qb = jnp.moveaxis(q.reshape(B, Hkv, G, nb, ATT_BLOCK, hd), 3, 0)
    scale = hd ** -0.5

    def one(qi):
        s = jnp.einsum('bkgqd,bksd->bkgqs', qi, k) * scale
        p = jax.nn.softmax(s, axis=-1)
        return jnp.einsum('bkgqs,bksd->bkgqd', p, v)

    o = lax.map(one, qb)
    return jnp.moveaxis(o, 0, 3).reshape(B, Hkv, G, S, hd)


def setup_inputs(seed: int = 0) -> dict:
    key = jax.random.key(seed)
    ks = jax.random.split(key, 20)
    f32 = jnp.float32
    nrm = lambda k, shape, s: (jax.random.normal(k, shape, f32) * s)
    gain = lambda k, shape: 1.0 + 0.05 * jax.random.normal(k, shape, f32)
    return {
        "x": jax.random.normal(ks[0], (BATCH, SEQ, D_MODEL), f32),
        "mix_norm": gain(ks[1], (DEPTH, D_MODEL)),
        "w_in": nrm(ks[2], (DEPTH, D_MODEL, D_IN), D_MODEL ** -0.5),
        "w_gk_fwd": nrm(ks[3], (DEPTH, GLA_RANK, GLA_QK), GLA_RANK ** -0.5),
        "b_gk_fwd": nrm(ks[4], (DEPTH, GLA_QK), 0.1),
        "w_gk_bwd": nrm(ks[5], (DEPTH, GLA_RANK, GLA_QK), GLA_RANK ** -0.5),
        "b_gk_bwd": nrm(ks[6], (DEPTH, GLA_QK), 0.1),
        "gla_norm": gain(ks[7], (DEPTH, GLA_DV)),
        "q_norm": gain(ks[8], (DEPTH, ATT_HD)),
        "k_norm": gain(ks[9], (DEPTH, ATT_HD)),
        "b_gate": nrm(ks[10], (DEPTH, 2, D_MODEL), 0.1),
        "w_o": nrm(ks[11], (DEPTH, D_MODEL, D_MODEL), D_MODEL ** -0.5),
        "ffn_norm": gain(ks[12], (DEPTH, D_MODEL)),
        "w_gate_up": nrm(ks[13], (DEPTH, D_MODEL, 2 * D_FF), D_MODEL ** -0.5),
        "w_down": nrm(ks[14], (DEPTH, D_FF, D_MODEL), D_FF ** -0.5),
        "final_norm": gain(ks[15], (D_MODEL,)),
    }


def reference(x, mix_norm, w_in, w_gk_fwd, b_gk_fwd, w_gk_bwd, b_gk_bwd, gla_norm,
              q_norm, k_norm, b_gate, w_o, ffn_norm, w_gate_up, w_down, final_norm):
    B, S, _ = x.shape
    dt = x.dtype
    rope = axial_rope_tables(S)
    points = split_points()

    def heads(t, n):
        return t.reshape(B, S, n, -1).transpose(0, 2, 1, 3)

    for l in range(DEPTH):
        h = rmsnorm(x, mix_norm[l])
        proj = h @ w_in[l]
        (g_q, g_k, g_v, g_out, g_rf, g_rb,
         a_q, a_k, a_v, gate_a, gate_b) = jnp.split(proj, points, axis=-1)

        qg = heads(g_q, GLA_HEADS) * (GLA_DK ** -0.5)
        kg = heads(g_k, GLA_HEADS)
        vg = heads(g_v, GLA_HEADS)
        la_f = heads(jax.nn.log_sigmoid((g_rf @ w_gk_fwd[l] + b_gk_fwd[l]).astype(jnp.float32)) / GLA_GATE_NORM, GLA_HEADS)
        la_b = heads(jax.nn.log_sigmoid((g_rb @ w_gk_bwd[l] + b_gk_bwd[l]).astype(jnp.float32)) / GLA_GATE_NORM, GLA_HEADS)
        o_f = gla_scan(qg, kg, vg, la_f, strict=False)
        flip = lambda t: jnp.flip(t, axis=2)
        o_b = flip(gla_scan(flip(qg), flip(kg), flip(vg), flip(la_b), strict=True))
        o_a = rmsnorm(o_f + o_b, gla_norm[l])
        y_a = (o_a.transpose(0, 2, 1, 3).reshape(B, S, GLA_V) * jax.nn.silu(g_out.astype(jnp.float32))).astype(dt)

        qa = rmsnorm(a_q.reshape(B, S, ATT_HEADS, ATT_HD), q_norm[l])
        ka = rmsnorm(a_k.reshape(B, S, ATT_KV_HEADS, ATT_HD), k_norm[l])
        qa = apply_axial_rope(qa, rope)
        ka = apply_axial_rope(ka, rope)
        G = ATT_HEADS // ATT_KV_HEADS
        qa = qa.reshape(B, S, ATT_KV_HEADS, G, ATT_HD).transpose(0, 2, 3, 1, 4)
        ka = ka.transpose(0, 2, 1, 3)
        va = heads(a_v, ATT_KV_HEADS).astype(jnp.float32)
        o_att = block_attention(qa, ka, va)
        y_b = o_att.transpose(0, 3, 1, 2, 4).reshape(B, S, ATT_Q).astype(dt)

        sg_a = jax.nn.sigmoid(gate_a + b_gate[l, 0])
        sg_b = jax.nn.sigmoid(gate_b + b_gate[l, 1])
        mixed = sg_a * y_a + sg_b * y_b
        x = x + mixed @ w_o[l]

        h2 = rmsnorm(x, ffn_norm[l])
        gu = h2 @ w_gate_up[l]
        gt, up = jnp.split(gu, 2, axis=-1)
        x = x + (jax.nn.silu(gt) * up) @ w_down[l]

    return rmsnorm(x, final_norm)
```

```cpp
#include <hip/hip_runtime.h>
#include <hip/hip_bf16.h>
#include <cstdio>
#include <cstdint>
#include <cmath>

#ifndef DIAG
#define DIAG 0
#endif
#ifndef MK_N_LAUNCHES
#define MK_N_LAUNCHES 1
#endif

constexpr int BATCH = 4, SEQ = 4096, DM = 1024, TOK = BATCH * SEQ;
constexpr int GH = 4, GDK = 128, GDV = 256, GRANK = 16;
constexpr int AH = 8, AKVH = 2, AHD = 128;
constexpr int DFF = 2816, DIN = 6688, NIN = 6912;
constexpr float EPS = 1e-6f;
constexpr int NWAVES = 8;

constexpr size_t MiB = 1u << 20;
constexpr size_t WS_CTL = 0, CTL_ZERO_BYTES = 1 * MiB;
constexpr size_t WS_WIN = 1 * MiB;
constexpr size_t WS_WO = 15 * MiB;
constexpr size_t WS_WGU = 17 * MiB;
constexpr size_t WS_WDN = 28 * MiB;
constexpr size_t WS_ROPE = 34 * MiB;
constexpr size_t WS_GR = 35 * MiB;
constexpr size_t WS_GQK = 40 * MiB;
constexpr size_t WS_GV = 72 * MiB;
constexpr size_t WS_UA = 104 * MiB;
constexpr size_t WS_SGB = 216 * MiB;
constexpr size_t WS_AQ = 168 * MiB;
constexpr size_t WS_AKV = 200 * MiB;
constexpr size_t WS_OF = 216 * MiB;
constexpr size_t WS_ACT = WS_GV;
constexpr size_t WS_END = 256 * MiB;
static_assert(WS_ACT + (size_t)TOK * DFF * 2 <= WS_AQ, "act overlay");
constexpr int CW_BAR = 4096;
constexpr int CW_RSQ1 = 32768;
constexpr int CW_RSQ2 = 65536;
static_assert((CW_RSQ2 + TOK) * 4 <= (int)CTL_ZERO_BYTES, "ctl");

constexpr int RING_BYTES = 131072;
constexpr int MISC_OFF = RING_BYTES + 320;
constexpr int LDS_BYTES = 147456;

#define GAS __attribute__((address_space(1)))
#define LAS __attribute__((address_space(3)))
typedef unsigned short bfu;
typedef unsigned v4u __attribute__((ext_vector_type(4)));
typedef unsigned v2u __attribute__((ext_vector_type(2)));
typedef GAS unsigned gu32;
#define RLX_AGENT __ATOMIC_RELAXED, __HIP_MEMORY_SCOPE_AGENT
#define LDS_WAIT() asm volatile("s_waitcnt lgkmcnt(0)" ::: "memory")
#define VM_WAIT() asm volatile("s_waitcnt vmcnt(0)" ::: "memory")
__device__ __forceinline__ unsigned f2bf(float f) { unsigned u = __builtin_bit_cast(unsigned, f); return (u + 0x7fffu + ((u >> 16) & 1u)) >> 16; }
__device__ __forceinline__ unsigned pk2(float lo, float hi) { return f2bf(lo) | (f2bf(hi) << 16); }
__device__ __forceinline__ float bf2f(unsigned short b) { return __builtin_bit_cast(float, (unsigned)b << 16); }
__device__ __forceinline__ float bflo(unsigned w) { return __builtin_bit_cast(float, w << 16); }
__device__ __forceinline__ float bfhi(unsigned w) { return __builtin_bit_cast(float, w & 0xffff0000u); }
__device__ __forceinline__ float sigmoidf_(float x) { return __builtin_amdgcn_rcpf(1.0f + __builtin_amdgcn_exp2f(-1.4426950408889634f * x)); }
__device__ __forceinline__ float wave_sum(float v) {
#pragma unroll
    for (int o = 1; o < 64; o <<= 1) v += __shfl_xor(v, o);
    return v;
}

namespace pg8 {
#define PG8_LAS __attribute__((address_space(3)))
typedef unsigned short bf16_t;
typedef short bf16x8 __attribute__((ext_vector_type(8)));
typedef float f32x4 __attribute__((ext_vector_type(4)));
typedef unsigned u32x4 __attribute__((ext_vector_type(4)));
constexpr int BM = 256, BK = 64, HALF = 128, HTB = HALF * BK * 2  , STAGE_BYTES = 8 * HTB, NXCD = 8, WGM = 8;

__host__ __device__ __forceinline__ int lds_byte(int r, int c) { const int st = (r >> 4) * 2 + (c >> 5), rr = r & 15, cc = c & 31, ob = rr * 64 + cc * 2; return st * 1024 + (ob ^ (((ob >> 9) & 1) << 5)); }
__host__ __device__ __forceinline__ void stage_rc(int b, int& R, int& C) { const int st = b / 1024, sb = b % 1024, swz = sb ^ (((sb >> 9) & 1) << 5); R = (st >> 1) * 16 + swz / 64; C = (st & 1) * 32 + (swz % 64) / 2; }
__host__ __device__ __forceinline__ int perm32(int rho) { const int n = rho >> 4, i = rho & 15; return 8 * (i >> 2) + 4 * n + (i & 3); }

struct Unit { int pm, pn; };
struct Gemm { const bf16_t* A; const bf16_t* Bt; int M, N, K; };

struct StaticOrder {
    int nM, nN, nwg, G, c;
    __host__ __device__ void init(int M, int N, int G_, int c_) { nM = M / BM; nN = N / BM; nwg = nM * nN; G = G_; c = c_; }
    __host__ __device__ bool next(int i, Unit& u) const {
        const long L = (long)i * G + c; if (L >= nwg) return false;
        int wgid = (int)L; { const int q = nwg / NXCD, r = nwg % NXCD, xcd = wgid % NXCD, off = wgid / NXCD; wgid = (xcd < r ? xcd * (q + 1) : r * (q + 1) + (xcd - r) * q) + off; }
        const int nig = WGM * nN, gid = wgid / nig, fm = gid * WGM, gsz = (nM - fm) < WGM ? (nM - fm) : WGM;
        u.pm = fm + ((wgid % nig) % gsz); u.pn = (wgid % nig) / gsz; return true;
    }
    __device__ __forceinline__ void a_ready(const Unit&) const {}
    __device__ __forceinline__ void done(const Unit&) const {}
};

typedef float f32x2 __attribute__((ext_vector_type(2)));
typedef __bf16 bf16x2v __attribute__((ext_vector_type(2)));
__device__ __forceinline__ unsigned cvt_pk_bf16(float lo, float hi) { const f32x2 v = {lo, hi}; return __builtin_bit_cast(unsigned, __builtin_convertvector(v, bf16x2v)); }

__device__ __forceinline__ float sigm(float x) { return __builtin_amdgcn_rcpf(1.0f + __builtin_amdgcn_exp2f(-1.4426950408889634f * x)); }
__device__ __forceinline__ u32x4 pack8(f32x4 a, f32x4 b) { u32x4 w; w.x = cvt_pk_bf16(a[0], a[1]); w.y = cvt_pk_bf16(a[2], a[3]); w.z = cvt_pk_bf16(b[0], b[1]); w.w = cvt_pk_bf16(b[2], b[3]); return w; }

struct EpiIn {
    static constexpr bool PERM = true, AFTER_DRAIN = false;
    bf16_t *GQK, *GV, *UA, *SGB, *AQ, *AKV; float* GR; const float* bgate;
    __device__ __forceinline__ void operator()(const f32x4 (&acc)[2][2][4][2], const Unit& u, int wr, int wc, int fr, int fq) const {
        const int pn = u.pn, row0 = u.pm * BM + wr * 64 + fr, cl = wc * 32 + 8 * fq;
        if (pn < 8 || (pn >= 16 && pn < 22)) {
            bf16_t* base; int ld, colt; float sc = 1.f;
            if (pn < 2) { base = GQK; ld = 1024; colt = pn * 256; sc = 0.08838834764831845f; }
            else if (pn < 4) { base = GQK; ld = 1024; colt = 512 + (pn - 2) * 256; }
            else if (pn < 8) { base = GV; ld = 1024; colt = (pn - 4) * 256; }
            else if (pn < 20) { base = AQ; ld = 1024; colt = (pn - 16) * 256; }
            else { base = AKV; ld = 512; colt = (pn - 20) * 256; }
#pragma unroll
            for (int ai = 0; ai < 2; ++ai)
#pragma unroll
                for (int m = 0; m < 4; ++m) { bf16_t* rowp = base + (size_t)(row0 + ai * HALF + m * 16) * ld + colt + cl;
#pragma unroll
                    for (int bj = 0; bj < 2; ++bj) *(u32x4*)(rowp + bj * HALF) = pack8(acc[ai][bj][m][0] * sc, acc[ai][bj][m][1] * sc); }
        } else if (pn < 16) {
            const int ub = (pn - 8) * 128 + cl;
            const f32x4 b0 = *(const f32x4*)(bgate + ub), b1 = *(const f32x4*)(bgate + ub + 4);
#pragma unroll
            for (int ai = 0; ai < 2; ++ai)
#pragma unroll
                for (int m = 0; m < 4; ++m) { f32x4 o[2];
#pragma unroll
                    for (int n = 0; n < 2; ++n) { const f32x4 g = acc[ai][0][m][n], a = acc[ai][1][m][n] + (n ? b1 : b0);
#pragma unroll
                        for (int j = 0; j < 4; ++j) o[n][j] = g[j] * sigm(g[j]) * sigm(a[j]); }
                    *(u32x4*)(UA + (size_t)(row0 + ai * HALF + m * 16) * 1024 + ub) = pack8(o[0], o[1]); }
        } else if (pn < 26) {
#pragma unroll
            for (int bj = 0; bj < 2; ++bj) { const int col = (pn - 22) * 256 + bj * HALF + cl;
                const f32x4 b0 = *(const f32x4*)(bgate + 1024 + col), b1 = *(const f32x4*)(bgate + 1024 + col + 4);
#pragma unroll
                for (int ai = 0; ai < 2; ++ai)
#pragma unroll
                    for (int m = 0; m < 4; ++m) { f32x4 o[2];
#pragma unroll
                        for (int n = 0; n < 2; ++n) { const f32x4 a = acc[ai][bj][m][n] + (n ? b1 : b0);
#pragma unroll
                            for (int j = 0; j < 4; ++j) o[n][j] = sigm(a[j]); }
                        *(u32x4*)(SGB + (size_t)(row0 + ai * HALF + m * 16) * 1024 + col) = pack8(o[0], o[1]); } }
        } else {
            if (wc == 0) {
#pragma unroll
                for (int ai = 0; ai < 2; ++ai)
#pragma unroll
                    for (int m = 0; m < 4; ++m) { float* rp = GR + (size_t)(row0 + ai * HALF + m * 16) * 32 + 8 * fq;
                        *(f32x4*)rp = acc[ai][0][m][0]; *(f32x4*)(rp + 4) = acc[ai][0][m][1]; }
            }
        }
    }
};
struct EpiRes {
    static constexpr bool PERM = false, AFTER_DRAIN = false;
    const float* xi; float* xo; bf16_t* xb; float* rsq;
    __device__ __forceinline__ void operator()(const f32x4 (&acc)[2][2][4][2], const Unit& u, int wr, int wc, int fr, int fq) const {
        const int row0 = u.pm * BM + wr * 64 + fr, col0 = u.pn * BM + wc * 32 + 4 * fq;
#pragma unroll
        for (int ai = 0; ai < 2; ++ai)
#pragma unroll
            for (int m = 0; m < 4; ++m) { const int row = row0 + ai * HALF + m * 16; const size_t off = (size_t)row * 1024 + col0; float ss = 0.f;
#pragma unroll
                for (int bj = 0; bj < 2; ++bj)
#pragma unroll
                    for (int n = 0; n < 2; ++n) { const size_t o2 = off + bj * HALF + n * 16; const f32x4 o = *(const f32x4*)(xi + o2) + acc[ai][bj][m][n];
                        *(f32x4*)(xo + o2) = o; ss += (o[0] * o[0] + o[1] * o[1]) + (o[2] * o[2] + o[3] * o[3]);
                        if (xb) { typedef unsigned u32x2v __attribute__((ext_vector_type(2))); u32x2v w; w.x = cvt_pk_bf16(o[0], o[1]); w.y = cvt_pk_bf16(o[2], o[3]); *(u32x2v*)(xb + o2) = w; } }
                ss += __shfl_xor(ss, 16); ss += __shfl_xor(ss, 32);
                if (fq == 0) atomicAdd(rsq + row, ss); }
    }
};
struct EpiGU {
    static constexpr bool PERM = true, AFTER_DRAIN = false;
    bf16_t* ACT; const float* rsq;
    __device__ __forceinline__ void operator()(const f32x4 (&acc)[2][2][4][2], const Unit& u, int wr, int wc, int fr, int fq) const {
        const int row0 = u.pm * BM + wr * 64 + fr, col = u.pn * 128 + wc * 32 + 8 * fq;
#pragma unroll
        for (int ai = 0; ai < 2; ++ai)
#pragma unroll
            for (int m = 0; m < 4; ++m) { const int row = row0 + ai * HALF + m * 16; const float rstd = 1.0f / sqrtf(rsq[row] * (1.0f / 1024.0f) + 1e-6f); f32x4 o[2];
#pragma unroll
                for (int n = 0; n < 2; ++n) { const f32x4 g = acc[ai][0][m][n] * rstd, v = acc[ai][1][m][n] * rstd;
#pragma unroll
                    for (int j = 0; j < 4; ++j) o[n][j] = g[j] * sigm(g[j]) * v[j]; }
                *(u32x4*)(ACT + (size_t)row * 2816 + col) = pack8(o[0], o[1]); }
    }
};
template <class Epi, class Sched, bool ALIGN_EPI = false, bool SP2 = false>
__device__ __forceinline__ void gemm_phase(PG8_LAS unsigned char* lds, const Gemm g, const Sched& S, const Epi& E, const int tid) {
    const int wid = __builtin_amdgcn_readfirstlane(tid >> 6), lane = tid & 63, wr = wid >> 2, wc = wid & 3, fr = lane & 15, fq = lane >> 4;
    const int K = g.K, nt = K / BK;
    unsigned voffA[2], voffB[2];
#pragma unroll
    for (int i = 0; i < 2; ++i) { int R, C; stage_rc(tid * 16 + i * 8192, R, C); const int Rb = Epi::PERM ? ((R & ~31) + perm32(R & 31)) : R;
        voffA[i] = (unsigned)(R * K + C) * 2u; voffB[i] = (unsigned)(Rb * K + C) * 2u; }
    const size_t kstep = (size_t)(BK * 2);
    const size_t hstep = (size_t)HALF * K * 2;
    const size_t tstep = 2 * hstep;
    const unsigned ldsw = (unsigned)wid * 1024u;
    const int aoff = lds_byte(wr * 64 + fr, fq * 8), boff = lds_byte(wc * 32 + fr, fq * 8);
#define PG8_SA(b, h) (((b) * 2 + (h)) * HTB)
#define PG8_SB(b, h) ((4 + (b) * 2 + (h)) * HTB)
#define PG8_STAGE(bufoff, gbase, voff) do { _Pragma("unroll") for (int _i = 0; _i < 2; ++_i) \
        __builtin_amdgcn_global_load_lds((const unsigned*)((const char*)(gbase) + (voff)[_i]), (PG8_LAS unsigned*)(lds + (bufoff) + ldsw + _i * 8192), 16, 0, 0); } while (0)
#define PG8_LDA(dst, b, h) do { _Pragma("unroll") for (int m = 0; m < 4; ++m) _Pragma("unroll") for (int k = 0; k < 2; ++k) dst[m][k] = *(const PG8_LAS bf16x8*)(lds + PG8_SA(b, h) + aoff + m * 2048 + k * 1024); } while (0)
#define PG8_LDB(dst, b, h) do { _Pragma("unroll") for (int n = 0; n < 2; ++n) _Pragma("unroll") for (int k = 0; k < 2; ++k) dst[n][k] = *(const PG8_LAS bf16x8*)(lds + PG8_SB(b, h) + boff + n * 2048 + k * 1024); } while (0)
#define PG8_MMA(ai, bj, At, Bt) do { __builtin_amdgcn_s_setprio(1); _Pragma("unroll") for (int m = 0; m < 4; ++m) _Pragma("unroll") for (int n = 0; n < 2; ++n) _Pragma("unroll") for (int k = 0; k < 2; ++k) \
        acc[ai][bj][m][n] = __builtin_amdgcn_mfma_f32_16x16x32_bf16(Bt[n][k], At[m][k], acc[ai][bj][m][n], 0, 0, 0); __builtin_amdgcn_s_setprio(0); } while (0)
#define PG8_WAIT_V(n) asm volatile("s_waitcnt vmcnt(" #n ")" ::: "memory")
#define PG8_WAIT_L(n) asm volatile("s_waitcnt lgkmcnt(" #n ")" ::: "memory")
#define PG8_BAR __builtin_amdgcn_s_barrier()
#define PG8_SCHED __builtin_amdgcn_sched_barrier(0)
    Unit cur, nxt; int ui = 0;
    if (!S.next(0, cur)) return;
    f32x4 acc[2][2][4][2];
#pragma unroll
    for (int a = 0; a < 2; ++a)
#pragma unroll
        for (int b = 0; b < 2; ++b)
#pragma unroll
            for (int m = 0; m < 4; ++m)
#pragma unroll
                for (int n = 0; n < 2; ++n) acc[a][b][m][n] = (f32x4){0.f, 0.f, 0.f, 0.f};
    bf16x8 At[4][2], B0[2][2], B1[2][2];
    const char* cA = (const char*)g.A + (size_t)cur.pm * tstep; const char* cB = (const char*)g.Bt + (size_t)cur.pn * tstep;
    S.a_ready(cur);
    if constexpr (SP2) {
        PG8_STAGE(PG8_SB(0, 0), cB, voffB); PG8_STAGE(PG8_SB(0, 1), cB + hstep, voffB); PG8_STAGE(PG8_SA(0, 0), cA, voffA); PG8_STAGE(PG8_SA(0, 1), cA + hstep, voffA);
        if (wr == 1) PG8_BAR;
        PG8_WAIT_V(2); PG8_BAR;
        PG8_STAGE(PG8_SB(1, 0), cB + kstep, voffB); PG8_STAGE(PG8_SA(1, 0), cA + kstep, voffA); PG8_STAGE(PG8_SB(1, 1), cB + hstep + kstep, voffB);
        PG8_WAIT_V(6); PG8_BAR;
    } else {
        PG8_STAGE(PG8_SB(0, 0), cB, voffB); PG8_STAGE(PG8_SA(0, 0), cA, voffA); PG8_STAGE(PG8_SB(0, 1), cB + hstep, voffB); PG8_STAGE(PG8_SA(0, 1), cA + hstep, voffA);
        if (wr == 1) PG8_BAR;
        PG8_WAIT_V(4); PG8_BAR;
        PG8_STAGE(PG8_SB(1, 0), cB + kstep, voffB); PG8_STAGE(PG8_SA(1, 0), cA + kstep, voffA); PG8_STAGE(PG8_SB(1, 1), cB + hstep + kstep, voffB);
        PG8_WAIT_V(6); PG8_BAR;
    }
    for (;;) {
        const bool has_next = S.next(ui + 1, nxt);
        const char* nA = has_next ? (const char*)g.A + (size_t)nxt.pm * tstep : cA; const char* nB = has_next ? (const char*)g.Bt + (size_t)nxt.pn * tstep : cB;
        for (int t = 0; t < nt; t += 2) {
            const bool last = (t == nt - 2);
            const char* a1 = cA + (size_t)(t + 1) * kstep;
            const char* a2 = last ? nA : cA + (size_t)(t + 2) * kstep; const char* b2 = last ? nB : cB + (size_t)(t + 2) * kstep;
            const char* a3 = a2 + kstep; const char* b3 = b2 + kstep;
            if (last && has_next) S.a_ready(nxt);
            if constexpr (SP2) {
            PG8_LDB(B0, 0, 0); PG8_LDB(B1, 0, 1); PG8_SCHED; PG8_LDA(At, 0, 0); PG8_STAGE(PG8_SA(1, 1), a1 + hstep, voffA);
            PG8_WAIT_V(8); PG8_WAIT_L(0); PG8_BAR; PG8_MMA(0, 0, At, B0); PG8_MMA(0, 1, At, B1); PG8_BAR; PG8_SCHED;
            PG8_LDA(At, 0, 1); PG8_STAGE(PG8_SB(0, 0), b2, voffB); PG8_STAGE(PG8_SB(0, 1), b2 + hstep, voffB); PG8_STAGE(PG8_SA(0, 0), a2, voffA);
            PG8_WAIT_V(8); PG8_WAIT_L(0); PG8_BAR; PG8_MMA(1, 0, At, B0); PG8_MMA(1, 1, At, B1); PG8_BAR; PG8_SCHED;
            PG8_LDB(B0, 1, 0); PG8_LDB(B1, 1, 1); PG8_SCHED; PG8_LDA(At, 1, 0); PG8_STAGE(PG8_SA(0, 1), a2 + hstep, voffA);
            PG8_WAIT_V(8); PG8_WAIT_L(0); PG8_BAR; PG8_MMA(0, 0, At, B0); PG8_MMA(0, 1, At, B1); PG8_BAR; PG8_SCHED;
            PG8_LDA(At, 1, 1); PG8_STAGE(PG8_SB(1, 0), b3, voffB); PG8_STAGE(PG8_SB(1, 1), b3 + hstep, voffB); PG8_STAGE(PG8_SA(1, 0), a3, voffA);
            PG8_WAIT_V(8); PG8_WAIT_L(0); PG8_BAR; PG8_MMA(1, 0, At, B0); PG8_MMA(1, 1, At, B1); PG8_BAR; PG8_SCHED;
            } else {
            PG8_LDB(B0, 0, 0); PG8_SCHED; PG8_LDA(At, 0, 0); PG8_STAGE(PG8_SA(1, 1), a1 + hstep, voffA);
            PG8_WAIT_L(8); PG8_BAR; PG8_WAIT_L(0); PG8_MMA(0, 0, At, B0); PG8_BAR; PG8_SCHED;
            PG8_LDB(B1, 0, 1); PG8_STAGE(PG8_SB(0, 0), b2, voffB);
            PG8_BAR; PG8_WAIT_L(0); PG8_MMA(0, 1, At, B1); PG8_BAR;
            PG8_LDA(At, 0, 1); PG8_STAGE(PG8_SA(0, 0), a2, voffA);
            PG8_BAR; PG8_WAIT_L(0); PG8_MMA(1, 0, At, B0); PG8_BAR; PG8_SCHED;
            PG8_STAGE(PG8_SB(0, 1), b2 + hstep, voffB);
            PG8_WAIT_V(6); PG8_BAR; PG8_MMA(1, 1, At, B1); PG8_BAR;
            PG8_LDB(B0, 1, 0); PG8_SCHED; PG8_LDA(At, 1, 0); PG8_STAGE(PG8_SA(0, 1), a2 + hstep, voffA);
            PG8_WAIT_L(8); PG8_BAR; PG8_WAIT_L(0); PG8_MMA(0, 0, At, B0); PG8_BAR; PG8_SCHED;
            PG8_LDB(B1, 1, 1); PG8_STAGE(PG8_SB(1, 0), b3, voffB);
            PG8_BAR; PG8_WAIT_L(0); PG8_MMA(0, 1, At, B1); PG8_BAR;
            PG8_LDA(At, 1, 1); PG8_STAGE(PG8_SA(1, 0), a3, voffA);
            PG8_BAR; PG8_WAIT_L(0); PG8_MMA(1, 0, At, B0); PG8_BAR; PG8_SCHED;
            PG8_STAGE(PG8_SB(1, 1), b3 + hstep, voffB);
            PG8_WAIT_V(6); PG8_BAR; PG8_MMA(1, 1, At, B1); PG8_BAR;
            }
        }
        if constexpr (ALIGN_EPI) { if (wr == 0) PG8_BAR; }
        if constexpr (!Epi::AFTER_DRAIN) { E(acc, cur, wr, wc, fr, fq); S.done(cur); }
        if (!has_next) break;
#pragma unroll
        for (int a = 0; a < 2; ++a)
#pragma unroll
            for (int b = 0; b < 2; ++b)
#pragma unroll
                for (int m = 0; m < 4; ++m)
#pragma unroll
                    for (int n = 0; n < 2; ++n) acc[a][b][m][n] = (f32x4){0.f, 0.f, 0.f, 0.f};
        cur = nxt; cA = nA; cB = nB; ++ui;
        if constexpr (ALIGN_EPI) { if (wr == 1) PG8_BAR; }
    }
    PG8_WAIT_V(0);
    if constexpr (!ALIGN_EPI) { if (wr == 0) PG8_BAR; }
    PG8_BAR;
    if constexpr (Epi::AFTER_DRAIN) { E.fused(acc, cur, wr, wc, fr, fq, lds, wid, lane); S.done(cur); }
#undef PG8_SA
#undef PG8_SB
#undef PG8_STAGE
#undef PG8_LDA
#undef PG8_LDB
#undef PG8_MMA
#undef PG8_WAIT_V
#undef PG8_WAIT_L
#undef PG8_BAR
#undef PG8_SCHED
}
}

namespace attn {
constexpr int D = 128, NW = 8, QBLK = 32, KVBLK = 64;
constexpr float SCALE = 0.088388347648318440f;
constexpr float THR = 8.f;
#ifndef ATTN_SDEPTH
#define ATTN_SDEPTH 1
#endif
constexpr int SDEPTH = ATTN_SDEPTH;
constexpr int LDQ = 1024, LDK = 512, LDO = 1024;
constexpr size_t SHM_V = KVBLK * D * 2, SHM_K = KVBLK * D * 2, SHM_ATTN = 2 * SHM_V + 2 * SHM_K + NW * 64 * 4;
using bf16 = __hip_bfloat16;
using bf16x8 = __attribute__((ext_vector_type(8))) short;
using s16x4  = __attribute__((ext_vector_type(4))) short;
using f32x16 = __attribute__((ext_vector_type(16))) float;
using f32x8  = __attribute__((ext_vector_type(8))) float;
using u32x4  = __attribute__((ext_vector_type(4))) unsigned;
#define KSWZ(row, colB) ((row) * 256 + ((colB) ^ (((row) & 7) << 4)))
#define SBAR() __builtin_amdgcn_sched_barrier(0)
__device__ __forceinline__ int crow(int r, int hi) { return (r & 3) + 8 * (r >> 2) + 4 * hi; }
typedef float f32x2a __attribute__((ext_vector_type(2))); typedef __bf16 bf16x2a __attribute__((ext_vector_type(2)));
__device__ __forceinline__ unsigned cvtpk(float lo, float hi) { const f32x2a v = {lo, hi}; return __builtin_bit_cast(unsigned, __builtin_convertvector(v, bf16x2a)); }
template <typename TIn> struct Stage;
template <> struct Stage<bf16>  { using T = bf16x8;
  __device__ static __forceinline__ T ld8(const bf16* p) { return *reinterpret_cast<const bf16x8*>(p); }
  __device__ static __forceinline__ bf16x8 tobf(T x) { return x; } };
template <> struct Stage<float> { using T = f32x8;
  __device__ static __forceinline__ T ld8(const float* p) { return *reinterpret_cast<const f32x8*>(p); }
  __device__ static __forceinline__ bf16x8 tobf(T x) {
    u32x4 w = {cvtpk(x[0], x[1]), cvtpk(x[2], x[3]), cvtpk(x[4], x[5]), cvtpk(x[6], x[7])}; return *reinterpret_cast<bf16x8*>(&w); } };

__device__ __forceinline__ void partialSM(f32x16& p0, f32x16& p1, float& m_reg, float& mn, float& alpha) {
  constexpr float C = SCALE * 1.4426950408889634f;
  float pmax = p0[0]; for (int r = 1; r < 16; ++r) pmax = fmaxf(pmax, p0[r]); for (int r = 0; r < 16; ++r) pmax = fmaxf(pmax, p1[r]);
  { auto rr = __builtin_amdgcn_permlane32_swap(__float_as_uint(pmax), __float_as_uint(pmax), false, false);
    pmax = fmaxf(__uint_as_float(rr[0]), __uint_as_float(rr[1])); }
  if (__builtin_expect(__all(pmax - m_reg <= THR / SCALE), 1)) { mn = m_reg; alpha = 1.f; }
  else { mn = fmaxf(m_reg, pmax); alpha = __builtin_amdgcn_exp2f((m_reg - mn) * C); m_reg = mn; }
  float mnC = -mn * C;
  for (int r = 0; r < 16; ++r) p0[r] = fmaf(p0[r], C, mnC); for (int r = 0; r < 16; ++r) p1[r] = fmaf(p1[r], C, mnC);
  for (int r = 0; r < 16; ++r) p0[r] = __builtin_amdgcn_exp2f(p0[r]);
}
__device__ __forceinline__ void finishSM(f32x16& p0, f32x16& p1, float alpha, float& l_reg, bf16x8& pa0, bf16x8& pa1, bf16x8& pa2, bf16x8& pa3) {
  for (int r = 0; r < 16; ++r) p1[r] = __builtin_amdgcn_exp2f(p1[r]);
  float ps = 0; for (int r = 0; r < 16; ++r) ps += p0[r]; for (int r = 0; r < 16; ++r) ps += p1[r];
  { auto rr = __builtin_amdgcn_permlane32_swap(__float_as_uint(ps), __float_as_uint(ps), false, false);
    ps = __uint_as_float(rr[0]) + __uint_as_float(rr[1]); }
  l_reg = l_reg * alpha + ps;
#define PK4(P, BASE, OUT) do { unsigned a0 = cvtpk(P[BASE + 0], P[BASE + 1]), a1 = cvtpk(P[BASE + 2], P[BASE + 3]);   \
    unsigned b0 = cvtpk(P[BASE + 4], P[BASE + 5]), b1 = cvtpk(P[BASE + 6], P[BASE + 7]);                              \
    auto r0 = __builtin_amdgcn_permlane32_swap(a0, b0, false, false); auto r1 = __builtin_amdgcn_permlane32_swap(a1, b1, false, false); \
    u32x4 w = {r0[0], r1[0], r0[1], r1[1]}; OUT = *reinterpret_cast<bf16x8*>(&w); } while (0)
  PK4(p0, 0, pa0); PK4(p0, 8, pa1); PK4(p1, 0, pa2); PK4(p1, 8, pa3);
#undef PK4
}
__device__ __forceinline__ void qkt(f32x16& p0, f32x16& p1, const bf16* Ks, const bf16x8* qr, int r32, int hi) {
  p0 = f32x16{}; p1 = f32x16{};
  for (int d0 = 0; d0 < 8; ++d0) { int cb = (d0 * 16 + hi * 8) * 2;
    bf16x8 b0 = *reinterpret_cast<const bf16x8*>((const char*)Ks + KSWZ(r32, cb));
    bf16x8 b1 = *reinterpret_cast<const bf16x8*>((const char*)Ks + KSWZ(32 + r32, cb));
    p0 = __builtin_amdgcn_mfma_f32_32x32x16_bf16(b0, qr[d0], p0, 0, 0, 0);
    p1 = __builtin_amdgcn_mfma_f32_32x32x16_bf16(b1, qr[d0], p1, 0, 0, 0); }
}
__device__ __forceinline__ int v_st(int k, int c) { const int kk = (k & ~0xC) | ((k & 4) << 1) | ((k & 8) >> 1); return ((kk >> 3) * 4 + (c >> 5)) * 512 + ((kk & 7) * 32 + (c & 31)) * 2; }
__device__ __forceinline__ int v_rd_base(int lane) { return ((lane & 3) << 3) | (((lane >> 2) & 3) << 6) | (((lane >> 4) & 1) << 5) | (((lane >> 5) & 1) << 8); }
constexpr int v_rd_off(int d0, int ks, int half) { return d0 * 512 + ks * 4096 + half * 2048; }
template <int OFF> __device__ __forceinline__ s16x4 tr_read(int vb) {
  s16x4 r; asm volatile("ds_read_b64_tr_b16 %0, %1 offset:%2" : "=&v"(r) : "v"(vb), "i"(OFF) : "memory"); return r;
}
template <int D0> __device__ __forceinline__ void pv_one(f32x16& od, int vb, bf16x8 pa0, bf16x8 pa1, bf16x8 pa2, bf16x8 pa3) {
  const s16x4 l0 = tr_read<v_rd_off(D0, 0, 0)>(vb), h0 = tr_read<v_rd_off(D0, 0, 1)>(vb), l1 = tr_read<v_rd_off(D0, 1, 0)>(vb), h1 = tr_read<v_rd_off(D0, 1, 1)>(vb);
  const s16x4 l2 = tr_read<v_rd_off(D0, 2, 0)>(vb), h2 = tr_read<v_rd_off(D0, 2, 1)>(vb), l3 = tr_read<v_rd_off(D0, 3, 0)>(vb), h3 = tr_read<v_rd_off(D0, 3, 1)>(vb);
  asm volatile("s_waitcnt lgkmcnt(0)" ::: "memory"); SBAR();
#define PK(L, H) (bf16x8){L[0], L[1], L[2], L[3], H[0], H[1], H[2], H[3]}
  od = __builtin_amdgcn_mfma_f32_32x32x16_bf16(pa0, PK(l0, h0), od, 0, 0, 0);
  od = __builtin_amdgcn_mfma_f32_32x32x16_bf16(pa1, PK(l1, h1), od, 0, 0, 0);
  od = __builtin_amdgcn_mfma_f32_32x32x16_bf16(pa2, PK(l2, h2), od, 0, 0, 0);
  od = __builtin_amdgcn_mfma_f32_32x32x16_bf16(pa3, PK(l3, h3), od, 0, 0, 0);
#undef PK
}
__device__ __forceinline__ void pv_d0(f32x16* o, int vb, bf16x8 pa0, bf16x8 pa1, bf16x8 pa2, bf16x8 pa3) {
  pv_one<0>(o[0], vb, pa0, pa1, pa2, pa3); pv_one<1>(o[1], vb, pa0, pa1, pa2, pa3); pv_one<2>(o[2], vb, pa0, pa1, pa2, pa3); pv_one<3>(o[3], vb, pa0, pa1, pa2, pa3);
}


__device__ __forceinline__ void attn_unit(const bfu* Qb, const bfu* __restrict__ Kh_, const bfu* __restrict__ Vh_, bfu* Ob,
                                          int t0, const float* __restrict__ qnorm, const float* __restrict__ tabc, const float* __restrict__ tabs, int seq, char* lds, const int tid) {
  const bf16* Kh = (const bf16*)Kh_; const bf16* Vh = (const bf16*)Vh_;
  using St = Stage<bf16>;
  const int wid = tid >> 6, lane = tid & 63, r32 = lane & 31, hi = lane >> 5;
  bf16* V_lds = (bf16*)lds; bf16* K_lds = (bf16*)(lds + 2 * SHM_V);
  float* ws = (float*)(lds + 2 * SHM_V + 2 * SHM_K) + wid * 64; float* li_l = ws; float* al_l = ws + 32;
  float m_reg = -1e30f, l_reg = 0; f32x16 o[4] = {}; bf16x8 qr[8];
#if DIAG == 3 || DIAG == 4
  { const bfu* Qw = Qb + (long)(wid * QBLK + r32) * LDQ + hi * 8;
#pragma unroll
    for (int d0 = 0; d0 < 8; ++d0) qr[d0] = *reinterpret_cast<const bf16x8*>(Qw + d0 * 16); }
#else
  {
    const bfu* Qw = Qb + (long)(wid * QBLK + r32) * LDQ + hi * 8;
    float qf[8][8]; float ss = 0.f;
#pragma unroll
    for (int d0 = 0; d0 < 8; ++d0) { const u32x4 w = *reinterpret_cast<const u32x4*>(Qw + d0 * 16);
#pragma unroll
      for (int j = 0; j < 4; ++j) { const float a = __builtin_bit_cast(float, w[j] << 16), b = __builtin_bit_cast(float, w[j] & 0xffff0000u); qf[d0][2 * j] = a; qf[d0][2 * j + 1] = b; ss += a * a + b * b; } }
    { auto rr = __builtin_amdgcn_permlane32_swap(__float_as_uint(ss), __float_as_uint(ss), false, false); ss = __uint_as_float(rr[0]) + __uint_as_float(rr[1]); }
    const float rstd = 1.0f / sqrtf(ss * (1.0f / 128.0f) + 1e-6f);
#pragma unroll
    for (int d0 = 0; d0 < 8; ++d0) { const float4 g0 = *reinterpret_cast<const float4*>(qnorm + d0 * 16 + hi * 8), g1 = *reinterpret_cast<const float4*>(qnorm + d0 * 16 + hi * 8 + 4);
      qf[d0][0] *= rstd * g0.x; qf[d0][1] *= rstd * g0.y; qf[d0][2] *= rstd * g0.z; qf[d0][3] *= rstd * g0.w; qf[d0][4] *= rstd * g1.x; qf[d0][5] *= rstd * g1.y; qf[d0][6] *= rstd * g1.z; qf[d0][7] *= rstd * g1.w; }
    const int t = t0 + wid * QBLK + r32, prow = t >> 6, pcol = t & 63;
#pragma unroll
    for (int a = 0; a < 2; ++a) { const int pos = a ? pcol : prow;
#pragma unroll
      for (int dp = 0; dp < 2; ++dp) { const int i0 = pos * 32 + dp * 16 + hi * 8;
#pragma unroll
        for (int j = 0; j < 8; ++j) { const float c = tabc[i0 + j], s = tabs[i0 + j]; const float x1 = qf[4 * a + dp][j], x2 = qf[4 * a + dp + 2][j];
          qf[4 * a + dp][j] = x1 * c - x2 * s; qf[4 * a + dp + 2][j] = x2 * c + x1 * s; } } }
#pragma unroll
    for (int d0 = 0; d0 < 8; ++d0) { u32x4 w = {cvtpk(qf[d0][0], qf[d0][1]), cvtpk(qf[d0][2], qf[d0][3]), cvtpk(qf[d0][4], qf[d0][5]), cvtpk(qf[d0][6], qf[d0][7])}; qr[d0] = *reinterpret_cast<bf16x8*>(&w); }
  }
#endif
  const int sr = tid >> 4, sc = (tid & 15) * 8, vst0 = v_st(sr, sc), vst1 = v_st(32 + sr, sc);
  const int vb0 = (int)(uintptr_t)V_lds + v_rd_base(lane);
  struct { typename St::T vs0, vs1, ks0, ks1; } sr_[SDEPTH];
#define SLOAD(i, k0) do { sr_[i].vs0 = St::ld8(&Vh[(long)((k0) + sr) * LDK + sc]); sr_[i].vs1 = St::ld8(&Vh[(long)((k0) + 32 + sr) * LDK + sc]); \
    sr_[i].ks0 = St::ld8(&Kh[(long)((k0) + sr) * LDK + sc]); sr_[i].ks1 = St::ld8(&Kh[(long)((k0) + 32 + sr) * LDK + sc]); } while (0)
#define SWRITE(b, i) do { *(bf16x8*)((char*)V_lds + (b) * SHM_V + vst0) = St::tobf(sr_[i].vs0);          \
    *(bf16x8*)((char*)V_lds + (b) * SHM_V + vst1) = St::tobf(sr_[i].vs1); int kc = sc * 2;               \
    *(bf16x8*)((char*)K_lds + (b) * SHM_K + KSWZ(sr, kc)) = St::tobf(sr_[i].ks0);                       \
    *(bf16x8*)((char*)K_lds + (b) * SHM_K + KSWZ(32 + sr, kc)) = St::tobf(sr_[i].ks1); } while (0)
#define SWAIT() do { if constexpr (SDEPTH == 2) asm volatile("s_waitcnt vmcnt(4)" ::: "memory"); else asm volatile("s_waitcnt vmcnt(0)" ::: "memory"); } while (0)
#define RESC(a) do { if (__any((a) < 1.f)) { if (hi == 0) al_l[r32] = (a); asm volatile("s_waitcnt lgkmcnt(0)" ::: "memory"); \
    for (int d = 0; d < 4; ++d) for (int r = 0; r < 16; ++r) o[d][r] *= al_l[crow(r, hi)]; } } while (0)
  f32x16 pA0, pA1, pB0, pB1; float mnA, mnB, alA, alB; bf16x8 pa0, pa1, pa2, pa3; const int NT = seq / KVBLK;
  constexpr int SE = 0, SO = SDEPTH - 1;
  SLOAD(SE, 0); asm volatile("s_waitcnt vmcnt(0)" ::: "memory"); SWRITE(0, SE); __syncthreads();
  qkt(pA0, pA1, K_lds, qr, r32, hi); partialSM(pA0, pA1, m_reg, mnA, alA);
  SLOAD(SO, KVBLK); if constexpr (SDEPTH == 2) { if (2 < NT) SLOAD(SE, 2 * KVBLK); }
  SWAIT(); SWRITE(1, SO); __syncthreads();
  for (int j = 1; j + 1 < NT; j += 2) {
    SBAR(); qkt(pB0, pB1, (bf16*)((char*)K_lds + SHM_K), qr, r32, hi);
    finishSM(pA0, pA1, alA, l_reg, pa0, pa1, pa2, pa3); SBAR();
    SLOAD(SO, (j + SDEPTH) * KVBLK); SBAR();
    pv_d0(o, vb0, pa0, pa1, pa2, pa3); partialSM(pB0, pB1, m_reg, mnB, alB);
    __syncthreads(); SWAIT(); SWRITE(0, SE);
    RESC(alB); __syncthreads();
    SBAR(); qkt(pA0, pA1, K_lds, qr, r32, hi);
    finishSM(pB0, pB1, alB, l_reg, pa0, pa1, pa2, pa3); SBAR();
    if (SDEPTH == 1 || j + 3 < NT) SLOAD(SE, (j + 1 + SDEPTH) * KVBLK); SBAR();
    pv_d0(o, vb0 + (int)SHM_V, pa0, pa1, pa2, pa3); partialSM(pA0, pA1, m_reg, mnA, alA);
    __syncthreads(); SWAIT(); SWRITE(1, SO);
    RESC(alA); __syncthreads();
  }
  SBAR(); qkt(pB0, pB1, (bf16*)((char*)K_lds + SHM_K), qr, r32, hi);
  finishSM(pA0, pA1, alA, l_reg, pa0, pa1, pa2, pa3); SBAR();
  pv_d0(o, vb0, pa0, pa1, pa2, pa3); partialSM(pB0, pB1, m_reg, mnB, alB);
  __syncthreads(); RESC(alB);
  finishSM(pB0, pB1, alB, l_reg, pa0, pa1, pa2, pa3); SBAR();
  pv_d0(o, vb0 + (int)SHM_V, pa0, pa1, pa2, pa3);
  if (hi == 0) li_l[r32] = l_reg; asm volatile("s_waitcnt lgkmcnt(0)" ::: "memory");
  float rli[16];
#pragma unroll
  for (int r = 0; r < 16; ++r) rli[r] = __builtin_amdgcn_rcpf(li_l[crow(r, hi)]);
  __syncthreads();
  { int et = tid; asm volatile("" : "+v"(et));
    const int ln = et & 63, ewid = et >> 6, er32 = ln & 31, ehi = ln >> 5;
    bfu* stg = (bfu*)lds + ewid * 4096; bfu* sw = stg + (4 * ehi) * 128 + er32;
#pragma unroll
    for (int r = 0; r < 16; ++r) { const int ro = (r & 3) + 8 * (r >> 2);
#pragma unroll
      for (int d0 = 0; d0 < 4; ++d0) sw[ro * 128 + d0 * 32] = (bfu)f2bf(o[d0][r] * rli[r]); }
    asm volatile("s_waitcnt lgkmcnt(0)" ::: "memory");
    const bfu* sp = stg + (ln >> 4) * 128 + (ln & 15) * 8;
    bfu* Ow = Ob + (long)(ewid * QBLK + (ln >> 4)) * LDO + (ln & 15) * 8;
#pragma unroll
    for (int i = 0; i < 8; ++i) { const u32x4 v = *(const u32x4*)(sp + i * 512); *(u32x4*)(Ow + (long)i * 4 * LDO) = v; }
  }
  __syncthreads();
#undef SLOAD
#undef SWRITE
#undef SWAIT
#undef RESC
}
#undef SBAR
#undef KSWZ
}
#define XB_TMO      128
#define XB_XCNT(j)  (256  + 64 * (j))
#define XB_XSUB(j)  (1280 + 64 * (j))
#define XB_XGEN(j)  (2304 + 64 * (j))
#define XB_TOP      3328
#define XB_TOPGEN   3392
#define XCD_BAR_WORDS 3456
#define XB_SPIN_CAP (1u << 18)

__device__ __forceinline__ unsigned xb_ld(unsigned* p)              { return __hip_atomic_load(p, __ATOMIC_RELAXED, __HIP_MEMORY_SCOPE_AGENT); }
__device__ __forceinline__ unsigned xb_add(unsigned* p, unsigned v) { return __hip_atomic_fetch_add(p, v, __ATOMIC_RELAXED, __HIP_MEMORY_SCOPE_AGENT); }
__device__ __forceinline__ unsigned xb_xcc_id() { return (unsigned)__builtin_amdgcn_s_getreg((3 << 11) | 20) & 0xFu; }
#define XB_SPIN(cond, bar) do { unsigned _sp = 0; while (cond) { __builtin_amdgcn_s_sleep(1); \
    if ((++_sp & 255u) == 0u) { if (xb_ld(&(bar)[XB_TMO])) break; if (_sp > XB_SPIN_CAP) { atomicAdd(&(bar)[XB_TMO], 1u); break; } } } } while (0)

struct XcdBarrier {
    unsigned* bar; unsigned x;
    volatile LAS unsigned* st;
};

__device__ __forceinline__ XcdBarrier xcd_barrier_post(unsigned* bar, volatile LAS unsigned* st) {
    XcdBarrier b; b.bar = bar; b.x = xb_xcc_id(); b.st = st;
    if (threadIdx.x == 0) (void)xb_add(&bar[XB_XCNT(b.x)], 1u);
    return b;
}
__device__ __forceinline__ void xcd_barrier_complete(unsigned* bar, unsigned x, unsigned& nloc, unsigned& nx) {
    const unsigned G = gridDim.x * gridDim.y * gridDim.z;
    unsigned sum, cnt, mine, sp = 0u;
    for (;;) {
        sum = 0u; cnt = 0u; mine = 0u;
#pragma unroll
        for (unsigned j = 0; j < 16; ++j) { const unsigned c = xb_ld(&bar[XB_XCNT(j)]); sum += c; cnt += (c > 0u) ? 1u : 0u; mine = (j == x) ? c : mine; }
        if (sum == G) break;
        __builtin_amdgcn_s_sleep(1);
        if ((++sp & 255u) == 0u) { if (xb_ld(&bar[XB_TMO])) break; if (sp > XB_SPIN_CAP) { atomicAdd(&bar[XB_TMO], 1u); break; } }
    }
    nloc = mine > 0u ? mine : 1u; nx = cnt > 0u ? cnt : 1u;
}

__device__ __forceinline__ void xcd_barrier(const XcdBarrier& b) {
    asm volatile("s_waitcnt vmcnt(0)" ::: "memory");
    __syncthreads();
    if (threadIdx.x == 0) {
        unsigned* bar = b.bar;
        __builtin_amdgcn_s_waitcnt(0);
        unsigned nloc = b.st[0], nx = b.st[1];
        if (nloc == 0u) { xcd_barrier_complete(bar, b.x, nloc, nx); b.st[0] = nloc; b.st[1] = nx; }
        const unsigned old = xb_add(&bar[XB_XSUB(b.x)], 1u);
        const unsigned gen = old / nloc;
        if (old + 1u == (gen + 1u) * nloc) {
            __builtin_amdgcn_fence(__ATOMIC_RELEASE, "agent");
            asm volatile("s_waitcnt vmcnt(0)" ::: "memory");
            const unsigned og = xb_add(&bar[XB_TOP], 1u);
            const unsigned tg = og / nx;
            if (og + 1u == (tg + 1u) * nx) xb_add(&bar[XB_TOPGEN], 1u);
            else XB_SPIN(xb_ld(&bar[XB_TOPGEN]) == tg, bar);
            __builtin_amdgcn_fence(__ATOMIC_ACQUIRE, "agent");
            xb_add(&bar[XB_XGEN(b.x)], 1u);
            asm volatile("s_waitcnt vmcnt(0)" ::: "memory");
        } else {
            XB_SPIN(xb_ld(&bar[XB_XGEN(b.x)]) == gen, bar);
            __builtin_amdgcn_fence(__ATOMIC_ACQUIRE, "agent");
            asm volatile("s_waitcnt vmcnt(0)" ::: "memory");
        }
    }
    __syncthreads();
}

__device__ __forceinline__ int fresh_tid(int wave_s) { int l; asm volatile("v_mbcnt_lo_u32_b32 %0, -1, 0\n\tv_mbcnt_hi_u32_b32 %0, -1, %0" : "=v"(l)); return wave_s * 64 + l; }
#define PHASE_IDS const int tid_ = fresh_tid(C.wave_s); const int lane_ = tid_ & 63; const int wave_ = __builtin_amdgcn_readfirstlane(tid_ >> 6); (void)lane_; (void)wave_
struct Ctx {
    LAS unsigned char* lds; char* ldsg; int vcu, G, wave_s;
    const float *x, *mix_norm, *w_in, *wgk_f, *bgk_f, *wgk_b, *bgk_b, *gla_norm, *q_norm, *k_norm, *b_gate, *w_o, *ffn_norm, *w_gu, *w_dn, *final_norm;
    float* out; unsigned char* ws;
};
#define WSP(T, off) ((T*)(C.ws + (off)))

__device__ __forceinline__ int src_col_in(int rho0) {
    const int tile = rho0 >> 8, c = rho0 & 255;
    if (tile < 8) return rho0;
    if (tile < 16) { const int u = tile - 8; return c < 128 ? 2048 + 128 * u + c : 4640 + 128 * u + (c - 128); }
    if (tile < 20) return 3104 + (tile - 16) * 256 + c;
    if (tile == 20) return 4128 + c;
    if (tile == 21) return 4384 + c;
    if (tile < 26) return 5664 + (tile - 22) * 256 + c;
    return c < 32 ? 3072 + c : -1;
}
__device__ __forceinline__ int src_col_gu(int rho0) { const int tile = rho0 >> 8, c = rho0 & 255; return c < 128 ? 128 * tile + c : 2816 + 128 * tile + (c - 128); }
__device__ __forceinline__ void p0_transpose_item(const float* W, int K, int N, bfu* WT, int dr0, int sc0, int k0, const float* g, LAS float* scr, int lane) {
    if (sc0 >= 0) {
#pragma unroll 8
        for (int i = 0; i < 32; ++i) { const int kk = 2 * i + (lane >> 5); float v = W[(size_t)(k0 + kk) * N + sc0 + (lane & 31)]; if (g) v *= g[k0 + kk]; scr[kk * 33 + (lane & 31)] = v; }
    } else {
#pragma unroll 8
        for (int i = 0; i < 32; ++i) { const int kk = 2 * i + (lane >> 5); scr[kk * 33 + (lane & 31)] = 0.f; }
    }
    LDS_WAIT(); asm volatile("" ::: "memory");
    const int c = lane & 7;
#pragma unroll
    for (int j = 0; j < 4; ++j) { const int n = (lane >> 3) + 8 * j; const LAS float* s = scr + (8 * c) * 33 + n;
        v4u o; o.x = pk2(s[0 * 33], s[1 * 33]); o.y = pk2(s[2 * 33], s[3 * 33]); o.z = pk2(s[4 * 33], s[5 * 33]); o.w = pk2(s[6 * 33], s[7 * 33]);
        *(GAS v4u*)(WT + (size_t)(dr0 + n) * K + k0 + 8 * c) = o; }
    LDS_WAIT(); asm volatile("" ::: "memory");
}
__device__ __forceinline__ void phase_prologue(const Ctx& C) {
    PHASE_IDS;
    LAS float* scr = (LAS float*)(C.lds + wave_ * 16384);
    const int gw = C.vcu * NWAVES + wave_, NGW = C.G * NWAVES;
    constexpr int I_IN = 16 * (NIN / 32), I_O = 16 * 32, I_GU = 16 * (2 * DFF / 32), I_DN = (DFF / 64) * 32;
    for (int it = gw; it < I_IN + I_O + I_GU + I_DN; it += NGW) {
        int r = it;
        if (r < I_IN) { const int kb = r / (NIN / 32), nb = r % (NIN / 32); p0_transpose_item(C.w_in, DM, DIN, WSP(bfu, WS_WIN), nb * 32, src_col_in(nb * 32), kb * 64, nullptr, scr, lane_); continue; } r -= I_IN;
        if (r < I_O) { const int kb = r / 32, nb = r % 32; p0_transpose_item(C.w_o, DM, DM, WSP(bfu, WS_WO), nb * 32, nb * 32, kb * 64, nullptr, scr, lane_); continue; } r -= I_O;
        if (r < I_GU) { const int kb = r / (2 * DFF / 32), nb = r % (2 * DFF / 32); p0_transpose_item(C.w_gu, DM, 2 * DFF, WSP(bfu, WS_WGU), nb * 32, src_col_gu(nb * 32), kb * 64, C.ffn_norm, scr, lane_); continue; } r -= I_GU;
        { const int kb = r / 32, nb = r % 32; p0_transpose_item(C.w_dn, DFF, DM, WSP(bfu, WS_WDN), nb * 32, nb * 32, kb * 64, nullptr, scr, lane_); }
    }
    bfu* H = (bfu*)C.out;
    for (int m = gw; m < TOK; m += NGW) {
        const float4* xr = (const float4*)(C.x + (size_t)m * DM) + lane_; float4 v[4]; float s = 0.f;
#pragma unroll
        for (int j = 0; j < 4; ++j) { v[j] = xr[64 * j]; s += (v[j].x * v[j].x + v[j].y * v[j].y) + (v[j].z * v[j].z + v[j].w * v[j].w); }
        const float rstd = 1.0f / sqrtf(wave_sum(s) * (1.f / DM) + EPS);
        unsigned long long* o8 = (unsigned long long*)(H + (size_t)m * DM) + lane_;
#pragma unroll
        for (int j = 0; j < 4; ++j) { const float4 g = *((const float4*)C.mix_norm + lane_ + 64 * j);
            o8[64 * j] = (unsigned long long)pk2(v[j].x * rstd * g.x, v[j].y * rstd * g.y) | ((unsigned long long)pk2(v[j].z * rstd * g.z, v[j].w * rstd * g.w) << 32); }
    }
    if (C.vcu == 0) { float* tc = WSP(float, WS_ROPE); float* ts = tc + 2048;
        for (int i = tid_; i < 2048; i += NWAVES * 64) { const int pos = i >> 5, f = i & 31; const float fr = powf(10000.0f, -(float)(2 * f) / 64.0f); const float ang = (float)pos * fr; tc[i] = cosf(ang); ts[i] = sinf(ang); } }
}
__device__ __forceinline__ void phase_knorm(const Ctx& C) {
    PHASE_IDS;
    const int gw = C.vcu * NWAVES + wave_, NGW = C.G * NWAVES; const float* tc = WSP(float, WS_ROPE); const float* ts = tc + 2048; bfu* AKV = WSP(bfu, WS_AKV);
    const int l31 = lane_ & 31;
    const float4 g = *((const float4*)C.k_norm + l31);
    for (int row = gw; row < TOK; row += NGW) {
        v2u* p = (v2u*)(AKV + (size_t)row * 512 + (lane_ >> 5) * 128) + l31; const v2u w = *p;
        float xv[4] = {bflo(w.x), bfhi(w.x), bflo(w.y), bfhi(w.y)};
        float ss = (xv[0] * xv[0] + xv[1] * xv[1]) + (xv[2] * xv[2] + xv[3] * xv[3]);
#pragma unroll
        for (int o = 1; o < 32; o <<= 1) ss += __shfl_xor(ss, o);
        const float rstd = 1.0f / sqrtf(ss * (1.f / 128.f) + EPS);
        xv[0] *= rstd * g.x; xv[1] *= rstd * g.y; xv[2] *= rstd * g.z; xv[3] *= rstd * g.w;
        const int t = row & (SEQ - 1); const int dim0 = 4 * l31; const int pos = (dim0 >> 6) ? (t & 63) : (t >> 6); const int i0 = pos * 32 + (dim0 & 31);
        float ov[4];
#pragma unroll
        for (int j = 0; j < 4; ++j) { const float pr = __shfl_xor(xv[j], 8); const float c = tc[i0 + j], s = ts[i0 + j]; ov[j] = (l31 & 8) ? (xv[j] * c + pr * s) : (xv[j] * c - pr * s); }
        v2u o; o.x = pk2(ov[0], ov[1]); o.y = pk2(ov[2], ov[3]); *p = o;
    }
}
__device__ __forceinline__ void phase_naive_qknorm(const Ctx& C) {
    PHASE_IDS; bfu* AQ = WSP(bfu, WS_AQ); bfu* AKV = WSP(bfu, WS_AKV);
    for (int idx = C.vcu * 512 + tid_; idx < TOK * 10; idx += C.G * 512) {
        const int row = idx / 10, hh = idx % 10; bfu* p = hh < 8 ? AQ + (size_t)row * 1024 + hh * 128 : AKV + (size_t)row * 512 + (hh - 8) * 128; const float* g = hh < 8 ? C.q_norm : C.k_norm;
        float ss = 0.f; for (int d = 0; d < 128; ++d) { const float v = bf2f(p[d]); ss += v * v; }
        const float rstd = 1.0f / sqrtf(ss / 128.0f + EPS); const int t = row & (SEQ - 1);
        for (int a = 0; a < 2; ++a) { const int pos = a ? (t & 63) : (t >> 6);
            for (int i = 0; i < 32; ++i) { const float fr = powf(10000.0f, -(float)(2 * i) / 64.0f), ang = (float)pos * fr, c = cosf(ang), s = sinf(ang);
                const float x1 = bf2f(p[64 * a + i]) * rstd * g[64 * a + i], x2 = bf2f(p[64 * a + 32 + i]) * rstd * g[64 * a + 32 + i];
                p[64 * a + i] = (bfu)f2bf(x1 * c - x2 * s); p[64 * a + 32 + i] = (bfu)f2bf(x2 * c + x1 * s); } }
    }
}
__device__ __forceinline__ void phase_check_attn(const Ctx& C) {
    PHASE_IDS; const int gw = C.vcu * NWAVES + wave_, NGW = C.G * NWAVES; const bfu* AQ = WSP(bfu, WS_AQ); const bfu* AKV = WSP(bfu, WS_AKV); const bfu* OFp = WSP(bfu, WS_OF); unsigned* ctl = WSP(unsigned, WS_CTL);
    for (int s = gw; s < 4096; s += NGW) {
        const int row = (int)(((long)s * 2053 + 17) % TOK), hq = s & 7, b = row >> 12, kvh = hq >> 2;
        const float q0 = bf2f(AQ[(size_t)row * 1024 + hq * 128 + 2 * lane_]), q1 = bf2f(AQ[(size_t)row * 1024 + hq * 128 + 2 * lane_ + 1]);
        float m = -1e30f, l = 0.f, o0 = 0.f, o1 = 0.f;
        for (int key = 0; key < SEQ; ++key) { const size_t kr = ((size_t)b * SEQ + key) * 512 + kvh * 128 + 2 * lane_;
            const float sc = wave_sum(q0 * bf2f(AKV[kr]) + q1 * bf2f(AKV[kr + 1])) * 0.08838834764831845f;
            const float mn = fmaxf(m, sc), a = expf(m - mn), p = expf(sc - mn); l = l * a + p; o0 = o0 * a + p * bf2f(AKV[kr + 256]); o1 = o1 * a + p * bf2f(AKV[kr + 257]); m = mn; }
        o0 /= l; o1 /= l;
        float e = fmaxf(fabsf(o0 - bf2f(OFp[(size_t)row * 1024 + hq * 128 + 2 * lane_])), fabsf(o1 - bf2f(OFp[(size_t)row * 1024 + hq * 128 + 2 * lane_ + 1])));
#pragma unroll
        for (int o = 1; o < 64; o <<= 1) e = fmaxf(e, __shfl_xor(e, o));
        if (lane_ == 0) { atomicMax(ctl + 1024, __float_as_uint(e)); if (e > 0.003f) atomicAdd(ctl + 1025, 1u); }
    }
}
__device__ __forceinline__ void phase_check_sgb(const Ctx& C, int slot) {
    PHASE_IDS; const int gw = C.vcu * NWAVES + wave_, NGW = C.G * NWAVES; const bfu* SG = WSP(bfu, WS_SGB); unsigned cnt = 0; float mxv = 0.f;
    for (int row = gw; row < TOK; row += NGW) for (int j = 0; j < 4; ++j) { const v2u w = *(const v2u*)(SG + (size_t)row * 1024 + j * 256 + 4 * lane_);
        mxv = fmaxf(mxv, fmaxf(fmaxf(fabsf(bflo(w.x)), fabsf(bfhi(w.x))), fmaxf(fabsf(bflo(w.y)), fabsf(bfhi(w.y)))));
        cnt += (fabsf(bflo(w.x)) > 1.f) + (fabsf(bfhi(w.x)) > 1.f) + (fabsf(bflo(w.y)) > 1.f) + (fabsf(bfhi(w.y)) > 1.f); }
    if (cnt) atomicAdd(WSP(unsigned, WS_CTL) + slot, cnt);
    atomicMax(WSP(unsigned, WS_CTL) + slot + 8, __float_as_uint(mxv));
}
__device__ __forceinline__ void diag_fill(const Ctx& C) {
    PHASE_IDS; unsigned* p = WSP(unsigned, WS_GQK); const size_t n = (WS_OF - WS_GQK) / 4;
    for (size_t i = (size_t)C.vcu * 512 + tid_; i < n; i += (size_t)C.G * 512) p[i] = 0x7F7F7F7Fu;
}
__device__ __forceinline__ void diag_count(const Ctx& C) {
    PHASE_IDS; const unsigned* p = WSP(unsigned, WS_GQK); const size_t n = (WS_OF - WS_GQK) / 4; unsigned c_sgb = 0, c_oth = 0;
    const size_t s0 = (WS_SGB - WS_GQK) / 4, s1 = (WS_AQ - WS_GQK) / 4;
    for (size_t i = (size_t)C.vcu * 512 + tid_; i < n; i += (size_t)C.G * 512) { const unsigned w = p[i]; const unsigned h = ((w & 0xffffu) == 0x7F7Fu) + ((w >> 16) == 0x7F7Fu);
        if (i >= s0 && i < s1) c_sgb += h; else c_oth += h; }
    if (c_sgb) atomicAdd(WSP(unsigned, WS_CTL) + 1030, c_sgb);
    if (c_oth) atomicAdd(WSP(unsigned, WS_CTL) + 1031, c_oth);
}
__device__ __forceinline__ void diag_check_p1(const Ctx& C) {
    PHASE_IDS; const int gw = C.vcu * NWAVES + wave_, NGW = C.G * NWAVES; const bfu* H = (const bfu*)C.out; const bfu* WT = WSP(bfu, WS_WIN);
    for (unsigned s = gw; s < (1u << 20); s += NGW) {
        const unsigned row = (s * 7919u) & 16383u, cs = ((s * 104729u) >> 3) & 2047u; unsigned rho; const bfu* dst; int isg = 0;
        if (cs < 1024u) { rho = 4096u + cs; dst = WSP(bfu, WS_AQ) + (size_t)row * 1024 + cs; }
        else if (cs < 1280u) { rho = 5376u + (cs - 1024u); dst = WSP(bfu, WS_AKV) + (size_t)row * 512 + 256 + (cs - 1024u); }
        else { const unsigned c = (cs - 1280u) & 1023u; rho = 5632u + c; dst = WSP(bfu, WS_SGB) + (size_t)row * 1024 + c; isg = 1 + (int)c; }
        float acc = 0.f;
        for (int k = lane_; k < 1024; k += 64) acc += bf2f(H[(size_t)row * 1024 + k]) * bf2f(WT[(size_t)rho * 1024 + k]);
        acc = wave_sum(acc);
        if (isg) acc = 1.0f / (1.0f + expf(-(acc + C.b_gate[1024 + isg - 1])));
        const float got = bf2f(*dst), e = fabsf(got - acc);
        if (lane_ == 0 && e > 0.03f + 0.02f * fabsf(acc)) atomicAdd(WSP(unsigned, WS_CTL) + 1040 + (isg ? 2 : (cs < 1024u ? 0 : 1)), 1u);
    }
}
__device__ __forceinline__ void diag_recompute_qkv(const Ctx& C) {
    PHASE_IDS; const int gw = C.vcu * NWAVES + wave_, NGW = C.G * NWAVES; const bfu* H = (const bfu*)C.out; const bfu* WT = WSP(bfu, WS_WIN);
    for (int it = gw; it < TOK * 24; it += NGW) { const int row = it / 24, cb = it % 24, c = cb * 64 + lane_;
        const bfu* w = WT + (size_t)(4096 + c) * 1024; const bfu* h = H + (size_t)row * 1024; float acc = 0.f;
        for (int k = 0; k < 1024; k += 8) { const v4u hv = *(const v4u*)(h + k), wv = *(const v4u*)(w + k);
            acc += bflo(hv.x) * bflo(wv.x) + bfhi(hv.x) * bfhi(wv.x) + bflo(hv.y) * bflo(wv.y) + bfhi(hv.y) * bfhi(wv.y) + bflo(hv.z) * bflo(wv.z) + bfhi(hv.z) * bfhi(wv.z) + bflo(hv.w) * bflo(wv.w) + bfhi(hv.w) * bfhi(wv.w); }
        bfu* dst = c < 1024 ? WSP(bfu, WS_AQ) + (size_t)row * 1024 + c : WSP(bfu, WS_AKV) + (size_t)row * 512 + (c - 1024);
        *dst = (bfu)f2bf(acc); }
}
__device__ __forceinline__ void gla_naive_item(const Ctx& C, int idx) {
    PHASE_IDS;
    const int dvg = idx & 3, dir = (idx >> 2) & 1, h = (idx >> 3) & 3, b = idx >> 5;
    LAS float* A_l = (LAS float*)C.lds; LAS float* Q_l = A_l + 64 * 128; LAS float* K_l = Q_l + 64 * 128; LAS float* V_l = K_l + 64 * 128;
    const float* GR = WSP(float, WS_GR); const bfu* GQK = WSP(bfu, WS_GQK); const bfu* GV = WSP(bfu, WS_GV); bfu* OFB = (bfu*)C.out + (size_t)dir * TOK * 1024;
    const float* wgk = dir ? C.wgk_b : C.wgk_f; const float* bgk = dir ? C.bgk_b : C.bgk_f;
    float s[16];
#pragma unroll
    for (int i = 0; i < 16; ++i) s[i] = 0.f;
    const int dvc = tid_ >> 3, part = tid_ & 7;
    for (int cc = 0; cc < 64; ++cc) {
        const int c = dir ? 63 - cc : cc; const size_t tok0 = (size_t)b * SEQ + c * 64;
        for (int e = 0; e < 16; ++e) { const int ie = tid_ + 512 * e, tk = ie >> 7, d = ie & 127;
            float xg = bgk[h * 128 + d]; const float* gr = GR + (tok0 + tk) * 32 + dir * 16;
#pragma unroll
            for (int r = 0; r < 16; ++r) xg += gr[r] * wgk[r * 512 + h * 128 + d];
            const float la = -(fmaxf(-xg, 0.f) + log1pf(expf(-fabsf(xg)))) * (1.0f / 16.0f);
            A_l[tk * 128 + d] = expf(la);
            Q_l[tk * 128 + d] = bf2f(GQK[(tok0 + tk) * 1024 + h * 128 + d]); K_l[tk * 128 + d] = bf2f(GQK[(tok0 + tk) * 1024 + 512 + h * 128 + d]); }
        for (int e = 0; e < 8; ++e) { const int ie = tid_ + 512 * e, tk = ie >> 6, dv = ie & 63; V_l[tk * 64 + dv] = bf2f(GV[(tok0 + tk) * 1024 + h * 256 + dvg * 64 + dv]); }
        __syncthreads();
        for (int tt = 0; tt < 64; ++tt) { const int tk = dir ? 63 - tt : tt; const float vv = V_l[tk * 64 + dvc]; float acc = 0.f;
#pragma unroll
            for (int i = 0; i < 16; ++i) { const int d = part * 16 + i; const float a = A_l[tk * 128 + d], kk = K_l[tk * 128 + d], q = Q_l[tk * 128 + d];
                if (dir == 0) { s[i] = a * s[i] + kk * vv; acc += q * s[i]; } else { const float tmp = a * s[i]; acc += q * tmp; s[i] = tmp + kk * vv; } }
            acc += __shfl_xor(acc, 1); acc += __shfl_xor(acc, 2); acc += __shfl_xor(acc, 4);
            if (part == 0) OFB[(tok0 + tk) * 1024 + h * 256 + dvg * 64 + dvc] = (bfu)f2bf(acc); }
        __syncthreads();
    }
}
__device__ __forceinline__ void phase_combine(const Ctx& C) {
    PHASE_IDS;
    const int gw = C.vcu * NWAVES + wave_, NGW = C.G * NWAVES; const bfu* OF = (const bfu*)C.out; const bfu* OB = OF + (size_t)TOK * 1024; const bfu* UA = WSP(bfu, WS_UA); const bfu* SG = WSP(bfu, WS_SGB); bfu* AQ = WSP(bfu, WS_AQ);
    const float4 gn = *((const float4*)C.gla_norm + lane_);
    for (int it = gw; it < TOK * 4; it += NGW) { const size_t base = (size_t)(it >> 2) * 1024 + (it & 3) * 256 + 4 * lane_;
        v2u a = *(const v2u*)(OF + base), bb = *(const v2u*)(OB + base), u = *(const v2u*)(UA + base), mb = *(const v2u*)((DIAG == 5 ? (const bfu*)WSP(bfu, WS_OF) : (const bfu*)AQ) + base), sg = *(const v2u*)(SG + base);
        const float o0 = bflo(a.x) + bflo(bb.x), o1 = bfhi(a.x) + bfhi(bb.x), o2 = bflo(a.y) + bflo(bb.y), o3 = bfhi(a.y) + bfhi(bb.y);
        const float rstd = 1.0f / sqrtf(wave_sum((o0 * o0 + o1 * o1) + (o2 * o2 + o3 * o3)) * (1.f / 256.f) + EPS);
#if DIAG == 1 || DIAG == 4
        mb.x = 0; mb.y = 0;
#endif
#if DIAG == 2
        u.x = 0; u.y = 0;
#endif
#if DIAG == 7
        { float mx = fmaxf(fmaxf(fabsf(bflo(mb.x)), fabsf(bfhi(mb.x))), fmaxf(fabsf(bflo(mb.y)), fabsf(bfhi(mb.y))));
          float sx = fmaxf(fmaxf(fabsf(bflo(sg.x)), fabsf(bfhi(sg.x))), fmaxf(fabsf(bflo(sg.y)), fabsf(bfhi(sg.y))));
#pragma unroll
          for (int o = 1; o < 64; o <<= 1) { mx = fmaxf(mx, __shfl_xor(mx, o)); sx = fmaxf(sx, __shfl_xor(sx, o)); }
          if (lane_ == 0) { atomicMax(WSP(unsigned, WS_CTL) + 1024, __float_as_uint(mx)); atomicMax(WSP(unsigned, WS_CTL) + 1025, __float_as_uint(sx)); if (mx > 0.5f) atomicAdd(WSP(unsigned, WS_CTL) + 1026, 1u); } }
        mb.x = 0; mb.y = 0;
#endif
#if DIAG == 12
        float m0 = bflo(mb.x) * fminf(fmaxf(bflo(sg.x), 0.f), 1.f), m1 = bfhi(mb.x) * fminf(fmaxf(bfhi(sg.x), 0.f), 1.f), m2 = bflo(mb.y) * fminf(fmaxf(bflo(sg.y), 0.f), 1.f), m3 = bfhi(mb.y) * fminf(fmaxf(bfhi(sg.y), 0.f), 1.f);
#else
        float m0 = bflo(mb.x) * bflo(sg.x), m1 = bfhi(mb.x) * bfhi(sg.x), m2 = bflo(mb.y) * bflo(sg.y), m3 = bfhi(mb.y) * bfhi(sg.y);
#endif
#if DIAG == 6
        m0 = fminf(fmaxf(m0, -0.15f), 0.15f); m1 = fminf(fmaxf(m1, -0.15f), 0.15f); m2 = fminf(fmaxf(m2, -0.15f), 0.15f); m3 = fminf(fmaxf(m3, -0.15f), 0.15f);
#endif
        v2u w; w.x = pk2(o0 * rstd * gn.x * bflo(u.x) + m0, o1 * rstd * gn.y * bfhi(u.x) + m1); w.y = pk2(o2 * rstd * gn.z * bflo(u.y) + m2, o3 * rstd * gn.w * bfhi(u.y) + m3);
        *(v2u*)(AQ + base) = w; }
}
__device__ __forceinline__ void phase_final(const Ctx& C) {
    PHASE_IDS;
    const int gw = C.vcu * NWAVES + wave_, NGW = C.G * NWAVES; const float* rsq = WSP(float, WS_CTL) + CW_RSQ2;
    for (int m = gw; m < TOK; m += NGW) { const float rstd = 1.0f / sqrtf(rsq[m] * (1.f / DM) + EPS); float4* xr = (float4*)(C.out + (size_t)m * DM) + lane_;
#pragma unroll
        for (int j = 0; j < 4; ++j) { float4 v = xr[64 * j]; const float4 g = *((const float4*)C.final_norm + lane_ + 64 * j); v.x *= rstd * g.x; v.y *= rstd * g.y; v.z *= rstd * g.z; v.w *= rstd * g.w; xr[64 * j] = v; } }
}
__device__ __forceinline__ void phase_attn(const Ctx& C) {
    const float* tc = WSP(float, WS_ROPE); const float* ts = tc + 2048; bfu* AQ = WSP(bfu, WS_AQ); const bfu* AKV = WSP(bfu, WS_AKV);
    for (int i = 0;; ++i) {
        int grp, uig;
        if (C.G == 256) { if (i >= 2) break; grp = C.vcu >> 5; uig = (C.vcu & 31) + 32 * i; }
        else { const int u = C.vcu + i * C.G; if (u >= 512) break; grp = u >> 6; uig = u & 63; }
        const int b = grp >> 1, kvh = grp & 1, hq = kvh * 4 + (uig >> 4), qb = uig & 15;
        const size_t r0 = (size_t)b * SEQ + qb * 256;
        attn::attn_unit(AQ + r0 * 1024 + hq * 128, AKV + (size_t)b * SEQ * 512 + kvh * 128, AKV + (size_t)b * SEQ * 512 + 256 + kvh * 128, ((DIAG == 4 || DIAG == 5) ? WSP(bfu, WS_OF) : AQ) + r0 * 1024 + hq * 128,
                        qb * 256, C.q_norm, tc, ts, SEQ, C.ldsg, fresh_tid(C.wave_s));
    }
}

constexpr int N_PHASES = 9;
struct Args { const float* in[16]; float* out; unsigned char* ws; int ph_lo, ph_hi; };
__global__ void __launch_bounds__(NWAVES * 64, 2) mk_fwd(Args args) {
    extern __shared__ __attribute__((aligned(16))) unsigned char lds[];
    Ctx C;
    C.lds = (LAS unsigned char*)lds; C.ldsg = (char*)lds;
    C.wave_s = __builtin_amdgcn_readfirstlane(threadIdx.x >> 6);
    C.G = gridDim.x; { const int bx = blockIdx.x; C.vcu = (C.G % 8 == 0) ? (bx % 8) * (C.G / 8) + bx / 8 : bx; }
    C.x = args.in[0]; C.mix_norm = args.in[1]; C.w_in = args.in[2]; C.wgk_f = args.in[3]; C.bgk_f = args.in[4]; C.wgk_b = args.in[5]; C.bgk_b = args.in[6]; C.gla_norm = args.in[7];
    C.q_norm = args.in[8]; C.k_norm = args.in[9]; C.b_gate = args.in[10]; C.w_o = args.in[11]; C.ffn_norm = args.in[12]; C.w_gu = args.in[13]; C.w_dn = args.in[14]; C.final_norm = args.in[15];
    C.out = args.out; C.ws = args.ws;
    volatile LAS unsigned* MISC = (volatile LAS unsigned*)(C.lds + MISC_OFF);
    for (int u = threadIdx.x; u < (LDS_BYTES - RING_BYTES) / 4; u += NWAVES * 64) ((LAS unsigned*)(C.lds + RING_BYTES))[u] = 0u;
    __syncthreads();
    unsigned* ctl = (unsigned*)(C.ws + WS_CTL);
    XcdBarrier bar; bar.bar = ctl + CW_BAR; bar.x = 0; bar.st = nullptr;
    if (MK_N_LAUNCHES == 1) bar = xcd_barrier_post(ctl + CW_BAR, MISC + 8);
#define GRID_BAR() do { if (MK_N_LAUNCHES == 1) xcd_barrier(bar); } while (0)
    const int lo = args.ph_lo, hi = args.ph_hi;
#ifdef ONLY_PHASE
#define IN(k) ((k) == ONLY_PHASE && lo <= (k) && (k) < hi)
#else
#define IN(k) (lo <= (k) && (k) < hi)
#endif
#define BOTH(k) (IN(k) && IN((k) + 1))
    float* RSQ1 = (float*)ctl + CW_RSQ1; float* RSQ2 = (float*)ctl + CW_RSQ2;

    if (IN(0)) {
#if DIAG == 9
        diag_fill(C);
#endif
        phase_prologue(C); if (BOTH(0)) GRID_BAR(); }
    if (IN(1)) {
        pg8::Gemm g{(const pg8::bf16_t*)C.out, WSP(pg8::bf16_t, WS_WIN), TOK, NIN, DM}; pg8::StaticOrder S; S.init(TOK, NIN, C.G, (int)blockIdx.x);
        pg8::EpiIn E{WSP(pg8::bf16_t, WS_GQK), WSP(pg8::bf16_t, WS_GV), WSP(pg8::bf16_t, WS_UA), WSP(pg8::bf16_t, WS_SGB), WSP(pg8::bf16_t, WS_AQ), WSP(pg8::bf16_t, WS_AKV), WSP(float, WS_GR), C.b_gate};
        pg8::gemm_phase<pg8::EpiIn, pg8::StaticOrder, true, true>(C.lds, g, S, E, fresh_tid(C.wave_s));
        if (BOTH(1)) GRID_BAR();
    }
    if (IN(2)) {
#if DIAG == 8
        phase_check_sgb(C, 1030);
#endif
#if DIAG == 9
        diag_count(C);
#endif
#if DIAG == 10
        diag_check_p1(C);
#endif
#if DIAG == 3 || DIAG == 4
        phase_naive_qknorm(C);
#else
        phase_knorm(C);
#endif
#if DIAG != 10
        for (int it = C.vcu; it < 128; it += C.G) gla_naive_item(C, it);
#endif
        if (BOTH(2)) GRID_BAR();
    }
    if (IN(3)) {
#if DIAG == 8
        phase_check_sgb(C, 1031);
#endif
        phase_attn(C); if (BOTH(3)) GRID_BAR(); }
    if (IN(4)) {
#if DIAG == 8
        phase_check_sgb(C, 1032);
#endif
#if DIAG == 4
        phase_check_attn(C);
#endif
        phase_combine(C); if (BOTH(4)) GRID_BAR(); }
    if (IN(5)) {
        pg8::Gemm g{WSP(pg8::bf16_t, WS_AQ), WSP(pg8::bf16_t, WS_WO), TOK, DM, DM}; pg8::StaticOrder S; S.init(TOK, DM, C.G, (int)blockIdx.x);
        pg8::EpiRes E{C.x, C.out, WSP(pg8::bf16_t, WS_GQK), RSQ1};
        pg8::gemm_phase<pg8::EpiRes, pg8::StaticOrder, true, true>(C.lds, g, S, E, fresh_tid(C.wave_s));
        if (BOTH(5)) GRID_BAR();
    }
    if (IN(6)) {
        pg8::Gemm g{WSP(pg8::bf16_t, WS_GQK), WSP(pg8::bf16_t, WS_WGU), TOK, 2 * DFF, DM}; pg8::StaticOrder S; S.init(TOK, 2 * DFF, C.G, (int)blockIdx.x);
        pg8::EpiGU E{WSP(pg8::bf16_t, WS_ACT), RSQ1};
        pg8::gemm_phase<pg8::EpiGU, pg8::StaticOrder, true, true>(C.lds, g, S, E, fresh_tid(C.wave_s));
        if (BOTH(6)) GRID_BAR();
    }
    if (IN(7)) {
        pg8::Gemm g{WSP(pg8::bf16_t, WS_ACT), WSP(pg8::bf16_t, WS_WDN), TOK, DM, DFF}; pg8::StaticOrder S; S.init(TOK, DM, C.G, (int)blockIdx.x);
        pg8::EpiRes E{C.out, C.out, nullptr, RSQ2};
        pg8::gemm_phase<pg8::EpiRes, pg8::StaticOrder, true, true>(C.lds, g, S, E, fresh_tid(C.wave_s));
        if (BOTH(7)) GRID_BAR();
    }
    if (IN(8)) { phase_final(C);
#if DIAG == 10
        if (blockIdx.x == 0 && threadIdx.x == 0) { C.out[0] = (float)ctl[1040] + 1e-3f * 0; C.out[1] = (float)ctl[1041]; C.out[2] = (float)ctl[1042]; }
#endif
#if DIAG == 9
        if (blockIdx.x == 0 && threadIdx.x == 0) { C.out[0] = (float)ctl[1030]; C.out[1] = ctl[1031] ? 5e5f : 0.f; }
#endif
#if DIAG == 8
        if (blockIdx.x == 0 && threadIdx.x == 0) { C.out[1] = 100.f * __uint_as_float(ctl[1038]); }
#endif
#if DIAG == 7
        if (blockIdx.x == 0 && threadIdx.x == 0) { C.out[0] = 10.f * __uint_as_float(ctl[1024]); C.out[1] = 1000.f * (__uint_as_float(ctl[1025]) > 1.0f ? 1.f : 0.f) + (float)ctl[1026]; }
#endif
#if DIAG == 4
        if (blockIdx.x == 0 && threadIdx.x == 0) { C.out[0] = 100.f * __uint_as_float(ctl[1024]); C.out[1] = 1000.f * ((float)ctl[1025] / 4096.0f); }
#endif
    }
#undef IN
#undef BOTH
}

extern "C" void kernel_launch(void* const* d_in, const int* in_sizes, int n_in, void* d_out, int out_size, void* d_ws, size_t ws_size, hipStream_t stream) {
    static int grid = 0;
    if (grid == 0) {
        if (n_in != 16 || in_sizes[0] != TOK * DM || out_size != TOK * DM || ws_size < WS_END) { fprintf(stderr, "kernel_launch: unexpected shapes (n_in %d, in0 %d, out %d, ws %zu)\n", n_in, n_in > 0 ? in_sizes[0] : -1, out_size, ws_size); grid = -1; return; }
        int dev = 0, cus = 0, per_cu = 0;
        if (hipGetDevice(&dev) != hipSuccess || hipDeviceGetAttribute(&cus, hipDeviceAttributeMultiprocessorCount, dev) != hipSuccess) { grid = -1; return; }
        if (hipFuncSetAttribute((const void*)mk_fwd, hipFuncAttributeMaxDynamicSharedMemorySize, LDS_BYTES) != hipSuccess) { fprintf(stderr, "kernel_launch: hipFuncSetAttribute failed\n"); grid = -1; return; }
        if (hipOccupancyMaxActiveBlocksPerMultiprocessor(&per_cu, (const void*)mk_fwd, NWAVES * 64, LDS_BYTES) != hipSuccess || per_cu < 1) { fprintf(stderr, "kernel_launch: occupancy query says %d blocks per CU\n", per_cu); }
        (void)hipGetLastError();
        grid = cus;
    }
    if (grid < 0) return;
    (void)hipMemsetAsync((char*)d_ws + WS_CTL, 0, CTL_ZERO_BYTES, stream);
    Args a{};
    for (int i = 0; i < 16; ++i) a.in[i] = (const float*)d_in[i];
    a.out = (float*)d_out; a.ws = (unsigned char*)d_ws;
    if (MK_N_LAUNCHES == 1) { a.ph_lo = 0; a.ph_hi = N_PHASES; hipLaunchKernelGGL(mk_fwd, dim3(grid), dim3(NWAVES * 64), LDS_BYTES, stream, a); }
    else for (int p = 0; p < N_PHASES; ++p) { a.ph_lo = p; a.ph_hi = p + 1; hipLaunchKernelGGL(mk_fwd, dim3(grid), dim3(NWAVES * 64), LDS_BYTES, stream, a); }
    const hipError_t le = hipPeekAtLastError();
    if (le != hipSuccess) fprintf(stderr, "kernel_launch: launch failed: %s\n", hipGetErrorName(le));
}
```

```cpp
#include <hip/hip_runtime.h>
#include <hip/hip_bf16.h>
#include <cstdio>
#include <cstdint>
#include <cmath>

#ifndef DIAG
#define DIAG 0
#endif
#ifndef MK_N_LAUNCHES
#define MK_N_LAUNCHES 1
#endif

constexpr int BATCH = 4, SEQ = 4096, DM = 1024, TOK = BATCH * SEQ;
constexpr int GH = 4, GDK = 128, GDV = 256, GRANK = 16;
constexpr int AH = 8, AKVH = 2, AHD = 128;
constexpr int DFF = 2816, DIN = 6688, NIN = 6912;
constexpr float EPS = 1e-6f;
constexpr int NWAVES = 8;

constexpr size_t MiB = 1u << 20;
constexpr size_t WS_CTL = 0, CTL_ZERO_BYTES = 1 * MiB;
constexpr size_t WS_WIN = 1 * MiB;
constexpr size_t WS_WO = 15 * MiB;
constexpr size_t WS_WGU = 17 * MiB;
constexpr size_t WS_WDN = 28 * MiB;
constexpr size_t WS_ROPE = 34 * MiB;
constexpr size_t WS_GR = 35 * MiB;
constexpr size_t WS_TOT = 38 * MiB;
constexpr size_t WS_GQK = 40 * MiB;
constexpr size_t WS_GV = 72 * MiB;
constexpr size_t WS_UA = 104 * MiB;
constexpr size_t WS_SGB = 136 * MiB;
constexpr size_t WS_AQ = 168 * MiB;
constexpr size_t WS_AKV = 200 * MiB;
constexpr size_t WS_OF = 216 * MiB;
constexpr size_t WS_ACT = WS_GV;
constexpr size_t WS_END = 256 * MiB;
static_assert(WS_ACT + (size_t)TOK * DFF * 2 <= WS_AQ, "act overlay");
constexpr int CW_BAR = 4096;
constexpr int CW_RSQ1 = 32768;
constexpr int CW_RSQ2 = 65536;
static_assert((CW_RSQ2 + TOK) * 4 <= (int)CTL_ZERO_BYTES, "ctl");

constexpr int RING_BYTES = 131072;
constexpr int MISC_OFF = RING_BYTES + 320;
constexpr int LDS_BYTES = 147456;

#define GAS __attribute__((address_space(1)))
#define LAS __attribute__((address_space(3)))
typedef unsigned short bfu;
typedef unsigned v4u __attribute__((ext_vector_type(4)));
typedef unsigned v2u __attribute__((ext_vector_type(2)));
typedef GAS unsigned gu32;
#define RLX_AGENT __ATOMIC_RELAXED, __HIP_MEMORY_SCOPE_AGENT
#define LDS_WAIT() asm volatile("s_waitcnt lgkmcnt(0)" ::: "memory")
#define VM_WAIT() asm volatile("s_waitcnt vmcnt(0)" ::: "memory")
__device__ __forceinline__ unsigned f2bf(float f) { unsigned u = __builtin_bit_cast(unsigned, f); return (u + 0x7fffu + ((u >> 16) & 1u)) >> 16; }
__device__ __forceinline__ unsigned pk2(float lo, float hi) { return f2bf(lo) | (f2bf(hi) << 16); }
__device__ __forceinline__ float bf2f(unsigned short b) { return __builtin_bit_cast(float, (unsigned)b << 16); }
__device__ __forceinline__ float bflo(unsigned w) { return __builtin_bit_cast(float, w << 16); }
__device__ __forceinline__ float bfhi(unsigned w) { return __builtin_bit_cast(float, w & 0xffff0000u); }
__device__ __forceinline__ float sigmoidf_(float x) { return __builtin_amdgcn_rcpf(1.0f + __builtin_amdgcn_exp2f(-1.4426950408889634f * x)); }
__device__ __forceinline__ float wave_sum(float v) {
#pragma unroll
    for (int o = 1; o < 64; o <<= 1) v += __shfl_xor(v, o);
    return v;
}

namespace pg8 {
#define PG8_LAS __attribute__((address_space(3)))
typedef unsigned short bf16_t;
typedef short bf16x8 __attribute__((ext_vector_type(8)));
typedef float f32x4 __attribute__((ext_vector_type(4)));
typedef unsigned u32x4 __attribute__((ext_vector_type(4)));
constexpr int BM = 256, BK = 64, HALF = 128, HTB = HALF * BK * 2  , STAGE_BYTES = 8 * HTB, NXCD = 8, WGM = 8;

__host__ __device__ __forceinline__ int lds_byte(int r, int c) { const int st = (r >> 4) * 2 + (c >> 5), rr = r & 15, cc = c & 31, ob = rr * 64 + cc * 2; return st * 1024 + (ob ^ (((ob >> 9) & 1) << 5)); }
__host__ __device__ __forceinline__ void stage_rc(int b, int& R, int& C) { const int st = b / 1024, sb = b % 1024, swz = sb ^ (((sb >> 9) & 1) << 5); R = (st >> 1) * 16 + swz / 64; C = (st & 1) * 32 + (swz % 64) / 2; }
__host__ __device__ __forceinline__ int perm32(int rho) { const int n = rho >> 4, i = rho & 15; return 8 * (i >> 2) + 4 * n + (i & 3); }

struct Unit { int pm, pn; };
struct Gemm { const bf16_t* A; const bf16_t* Bt; int M, N, K; };

struct StaticOrder {
    int nM, nN, nwg, G, c;
    __host__ __device__ void init(int M, int N, int G_, int c_) { nM = M / BM; nN = N / BM; nwg = nM * nN; G = G_; c = c_; }
    __host__ __device__ bool next(int i, Unit& u) const {
        const long L = (long)i * G + c; if (L >= nwg) return false;
        int wgid = (int)L; { const int q = nwg / NXCD, r = nwg % NXCD, xcd = wgid % NXCD, off = wgid / NXCD; wgid = (xcd < r ? xcd * (q + 1) : r * (q + 1) + (xcd - r) * q) + off; }
        const int nig = WGM * nN, gid = wgid / nig, fm = gid * WGM, gsz = (nM - fm) < WGM ? (nM - fm) : WGM;
        u.pm = fm + ((wgid % nig) % gsz); u.pn = (wgid % nig) / gsz; return true;
    }
    __device__ __forceinline__ void a_ready(const Unit&) const {}
    __device__ __forceinline__ void done(const Unit&) const {}
};

typedef float f32x2 __attribute__((ext_vector_type(2)));
typedef __bf16 bf16x2v __attribute__((ext_vector_type(2)));
__device__ __forceinline__ unsigned cvt_pk_bf16(float lo, float hi) { const f32x2 v = {lo, hi}; return __builtin_bit_cast(unsigned, __builtin_convertvector(v, bf16x2v)); }

__device__ __forceinline__ float sigm(float x) { return __builtin_amdgcn_rcpf(1.0f + __builtin_amdgcn_exp2f(-1.4426950408889634f * x)); }
__device__ __forceinline__ u32x4 pack8(f32x4 a, f32x4 b) { u32x4 w; w.x = cvt_pk_bf16(a[0], a[1]); w.y = cvt_pk_bf16(a[2], a[3]); w.z = cvt_pk_bf16(b[0], b[1]); w.w = cvt_pk_bf16(b[2], b[3]); return w; }

struct EpiIn {
    static constexpr bool PERM = true, AFTER_DRAIN = false;
    bf16_t *GQK, *GV, *UA, *SGB, *AQ, *AKV; float* GR; const float* bgate;
    __device__ __forceinline__ void operator()(const f32x4 (&acc)[2][2][4][2], const Unit& u, int wr, int wc, int fr, int fq) const {
        const int pn = u.pn, row0 = u.pm * BM + wr * 64 + fr, cl = wc * 32 + 8 * fq;
        if (pn < 8 || (pn >= 16 && pn < 22)) {
            bf16_t* base; int ld, colt; float sc = 1.f;
            if (pn < 2) { base = GQK; ld = 1024; colt = pn * 256; sc = 0.08838834764831845f; }
            else if (pn < 4) { base = GQK; ld = 1024; colt = 512 + (pn - 2) * 256; }
            else if (pn < 8) { base = GV; ld = 1024; colt = (pn - 4) * 256; }
            else if (pn < 20) { base = AQ; ld = 1024; colt = (pn - 16) * 256; }
            else { base = AKV; ld = 512; colt = (pn - 20) * 256; }
#pragma unroll
            for (int ai = 0; ai < 2; ++ai)
#pragma unroll
                for (int m = 0; m < 4; ++m) { bf16_t* rowp = base + (size_t)(row0 + ai * HALF + m * 16) * ld + colt + cl;
#pragma unroll
                    for (int bj = 0; bj < 2; ++bj) *(u32x4*)(rowp + bj * HALF) = pack8(acc[ai][bj][m][0] * sc, acc[ai][bj][m][1] * sc); }
        } else if (pn < 16) {
            const int ub = (pn - 8) * 128 + cl;
            const f32x4 b0 = *(const f32x4*)(bgate + ub), b1 = *(const f32x4*)(bgate + ub + 4);
#pragma unroll
            for (int ai = 0; ai < 2; ++ai)
#pragma unroll
                for (int m = 0; m < 4; ++m) { f32x4 o[2];
#pragma unroll
                    for (int n = 0; n < 2; ++n) { const f32x4 g = acc[ai][0][m][n], a = acc[ai][1][m][n] + (n ? b1 : b0);
#pragma unroll
                        for (int j = 0; j < 4; ++j) o[n][j] = g[j] * sigm(g[j]) * sigm(a[j]); }
                    *(u32x4*)(UA + (size_t)(row0 + ai * HALF + m * 16) * 1024 + ub) = pack8(o[0], o[1]); }
        } else if (pn < 26) {
#pragma unroll
            for (int bj = 0; bj < 2; ++bj) { const int col = (pn - 22) * 256 + bj * HALF + cl;
                const f32x4 b0 = *(const f32x4*)(bgate + 1024 + col), b1 = *(const f32x4*)(bgate + 1024 + col + 4);
#pragma unroll
                for (int ai = 0; ai < 2; ++ai)
#pragma unroll
                    for (int m = 0; m < 4; ++m) { f32x4 o[2];
#pragma unroll
                        for (int n = 0; n < 2; ++n) { const f32x4 a = acc[ai][bj][m][n] + (n ? b1 : b0);
#pragma unroll
                            for (int j = 0; j < 4; ++j) o[n][j] = sigm(a[j]); }
                        *(u32x4*)(SGB + (size_t)(row0 + ai * HALF + m * 16) * 1024 + col) = pack8(o[0], o[1]); } }
        } else {
            if (wc == 0) {
#pragma unroll
                for (int ai = 0; ai < 2; ++ai)
#pragma unroll
                    for (int m = 0; m < 4; ++m) { float* rp = GR + (size_t)(row0 + ai * HALF + m * 16) * 32 + 8 * fq;
                        *(f32x4*)rp = acc[ai][0][m][0]; *(f32x4*)(rp + 4) = acc[ai][0][m][1]; }
            }
        }
    }
};
struct EpiRes {
    static constexpr bool PERM = false, AFTER_DRAIN = false;
    const float* xi; float* xo; bf16_t* xb; float* rsq;
    __device__ __forceinline__ void operator()(const f32x4 (&acc)[2][2][4][2], const Unit& u, int wr, int wc, int fr, int fq) const {
        const int row0 = u.pm * BM + wr * 64 + fr, col0 = u.pn * BM + wc * 32 + 4 * fq;
#pragma unroll
        for (int ai = 0; ai < 2; ++ai)
#pragma unroll
            for (int m = 0; m < 4; ++m) { const int row = row0 + ai * HALF + m * 16; const size_t off = (size_t)row * 1024 + col0; float ss = 0.f;
#pragma unroll
                for (int bj = 0; bj < 2; ++bj)
#pragma unroll
                    for (int n = 0; n < 2; ++n) { const size_t o2 = off + bj * HALF + n * 16; const f32x4 o = *(const f32x4*)(xi + o2) + acc[ai][bj][m][n];
                        *(f32x4*)(xo + o2) = o; ss += (o[0] * o[0] + o[1] * o[1]) + (o[2] * o[2] + o[3] * o[3]);
                        if (xb) { typedef unsigned u32x2v __attribute__((ext_vector_type(2))); u32x2v w; w.x = cvt_pk_bf16(o[0], o[1]); w.y = cvt_pk_bf16(o[2], o[3]); *(u32x2v*)(xb + o2) = w; } }
                ss += __shfl_xor(ss, 16); ss += __shfl_xor(ss, 32);
                if (fq == 0) atomicAdd(rsq + row, ss); }
    }
};
struct EpiGU {
    static constexpr bool PERM = true, AFTER_DRAIN = false;
    bf16_t* ACT; const float* rsq;
    __device__ __forceinline__ void operator()(const f32x4 (&acc)[2][2][4][2], const Unit& u, int wr, int wc, int fr, int fq) const {
        const int row0 = u.pm * BM + wr * 64 + fr, col = u.pn * 128 + wc * 32 + 8 * fq;
#pragma unroll
        for (int ai = 0; ai < 2; ++ai)
#pragma unroll
            for (int m = 0; m < 4; ++m) { const int row = row0 + ai * HALF + m * 16; const float rstd = 1.0f / sqrtf(rsq[row] * (1.0f / 1024.0f) + 1e-6f); f32x4 o[2];
#pragma unroll
                for (int n = 0; n < 2; ++n) { const f32x4 g = acc[ai][0][m][n] * rstd, v = acc[ai][1][m][n] * rstd;
#pragma unroll
                    for (int j = 0; j < 4; ++j) o[n][j] = g[j] * sigm(g[j]) * v[j]; }
                *(u32x4*)(ACT + (size_t)row * 2816 + col) = pack8(o[0], o[1]); }
    }
};
template <class Epi, class Sched, bool ALIGN_EPI = false, bool SP2 = false>
__device__ __forceinline__ void gemm_phase(PG8_LAS unsigned char* lds, const Gemm g, const Sched& S, const Epi& E, const int tid) {
    const int wid = __builtin_amdgcn_readfirstlane(tid >> 6), lane = tid & 63, wr = wid >> 2, wc = wid & 3, fr = lane & 15, fq = lane >> 4;
    const int K = g.K, nt = K / BK;
    unsigned voffA[2], voffB[2];
#pragma unroll
    for (int i = 0; i < 2; ++i) { int R, C; stage_rc(tid * 16 + i * 8192, R, C); const int Rb = Epi::PERM ? ((R & ~31) + perm32(R & 31)) : R;
        voffA[i] = (unsigned)(R * K + C) * 2u; voffB[i] = (unsigned)(Rb * K + C) * 2u; }
    const size_t kstep = (size_t)(BK * 2);
    const size_t hstep = (size_t)HALF * K * 2;
    const size_t tstep = 2 * hstep;
    const unsigned ldsw = (unsigned)wid * 1024u;
    const int aoff = lds_byte(wr * 64 + fr, fq * 8), boff = lds_byte(wc * 32 + fr, fq * 8);
#define PG8_SA(b, h) (((b) * 2 + (h)) * HTB)
#define PG8_SB(b, h) ((4 + (b) * 2 + (h)) * HTB)
#define PG8_STAGE(bufoff, gbase, voff) do { _Pragma("unroll") for (int _i = 0; _i < 2; ++_i) \
        __builtin_amdgcn_global_load_lds((const unsigned*)((const char*)(gbase) + (voff)[_i]), (PG8_LAS unsigned*)(lds + (bufoff) + ldsw + _i * 8192), 16, 0, 0); } while (0)
#define PG8_LDA(dst, b, h) do { _Pragma("unroll") for (int m = 0; m < 4; ++m) _Pragma("unroll") for (int k = 0; k < 2; ++k) dst[m][k] = *(const PG8_LAS bf16x8*)(lds + PG8_SA(b, h) + aoff + m * 2048 + k * 1024); } while (0)
#define PG8_LDB(dst, b, h) do { _Pragma("unroll") for (int n = 0; n < 2; ++n) _Pragma("unroll") for (int k = 0; k < 2; ++k) dst[n][k] = *(const PG8_LAS bf16x8*)(lds + PG8_SB(b, h) + boff + n * 2048 + k * 1024); } while (0)
#define PG8_MMA(ai, bj, At, Bt) do { __builtin_amdgcn_s_setprio(1); _Pragma("unroll") for (int m = 0; m < 4; ++m) _Pragma("unroll") for (int n = 0; n < 2; ++n) _Pragma("unroll") for (int k = 0; k < 2; ++k) \
        acc[ai][bj][m][n] = __builtin_amdgcn_mfma_f32_16x16x32_bf16(Bt[n][k], At[m][k], acc[ai][bj][m][n], 0, 0, 0); __builtin_amdgcn_s_setprio(0); } while (0)
#define PG8_WAIT_V(n) asm volatile("s_waitcnt vmcnt(" #n ")" ::: "memory")
#define PG8_WAIT_L(n) asm volatile("s_waitcnt lgkmcnt(" #n ")" ::: "memory")
#define PG8_BAR __builtin_amdgcn_s_barrier()
#define PG8_SCHED __builtin_amdgcn_sched_barrier(0)
    Unit cur, nxt; int ui = 0;
    if (!S.next(0, cur)) return;
    f32x4 acc[2][2][4][2];
#pragma unroll
    for (int a = 0; a < 2; ++a)
#pragma unroll
        for (int b = 0; b < 2; ++b)
#pragma unroll
            for (int m = 0; m < 4; ++m)
#pragma unroll
                for (int n = 0; n < 2; ++n) acc[a][b][m][n] = (f32x4){0.f, 0.f, 0.f, 0.f};
    bf16x8 At[4][2], B0[2][2], B1[2][2];
    const char* cA = (const char*)g.A + (size_t)cur.pm * tstep; const char* cB = (const char*)g.Bt + (size_t)cur.pn * tstep;
    S.a_ready(cur);
    if constexpr (SP2) {
        PG8_STAGE(PG8_SB(0, 0), cB, voffB); PG8_STAGE(PG8_SB(0, 1), cB + hstep, voffB); PG8_STAGE(PG8_SA(0, 0), cA, voffA); PG8_STAGE(PG8_SA(0, 1), cA + hstep, voffA);
        if (wr == 1) PG8_BAR;
        PG8_WAIT_V(2); PG8_BAR;
        PG8_STAGE(PG8_SB(1, 0), cB + kstep, voffB); PG8_STAGE(PG8_SA(1, 0), cA + kstep, voffA); PG8_STAGE(PG8_SB(1, 1), cB + hstep + kstep, voffB);
        PG8_WAIT_V(6); PG8_BAR;
    } else {
        PG8_STAGE(PG8_SB(0, 0), cB, voffB); PG8_STAGE(PG8_SA(0, 0), cA, voffA); PG8_STAGE(PG8_SB(0, 1), cB + hstep, voffB); PG8_STAGE(PG8_SA(0, 1), cA + hstep, voffA);
        if (wr == 1) PG8_BAR;
        PG8_WAIT_V(4); PG8_BAR;
        PG8_STAGE(PG8_SB(1, 0), cB + kstep, voffB); PG8_STAGE(PG8_SA(1, 0), cA + kstep, voffA); PG8_STAGE(PG8_SB(1, 1), cB + hstep + kstep, voffB);
        PG8_WAIT_V(6); PG8_BAR;
    }
    for (;;) {
        const bool has_next = S.next(ui + 1, nxt);
        const char* nA = has_next ? (const char*)g.A + (size_t)nxt.pm * tstep : cA; const char* nB = has_next ? (const char*)g.Bt + (size_t)nxt.pn * tstep : cB;
        for (int t = 0; t < nt; t += 2) {
            const bool last = (t == nt - 2);
            const char* a1 = cA + (size_t)(t + 1) * kstep;
            const char* a2 = last ? nA : cA + (size_t)(t + 2) * kstep; const char* b2 = last ? nB : cB + (size_t)(t + 2) * kstep;
            const char* a3 = a2 + kstep; const char* b3 = b2 + kstep;
            if (last && has_next) S.a_ready(nxt);
            if constexpr (SP2) {
            PG8_LDB(B0, 0, 0); PG8_LDB(B1, 0, 1); PG8_SCHED; PG8_LDA(At, 0, 0); PG8_STAGE(PG8_SA(1, 1), a1 + hstep, voffA);
            PG8_WAIT_V(8); PG8_WAIT_L(0); PG8_BAR; PG8_MMA(0, 0, At, B0); PG8_MMA(0, 1, At, B1); PG8_BAR; PG8_SCHED;
            PG8_LDA(At, 0, 1); PG8_STAGE(PG8_SB(0, 0), b2, voffB); PG8_STAGE(PG8_SB(0, 1), b2 + hstep, voffB); PG8_STAGE(PG8_SA(0, 0), a2, voffA);
            PG8_WAIT_V(8); PG8_WAIT_L(0); PG8_BAR; PG8_MMA(1, 0, At, B0); PG8_MMA(1, 1, At, B1); PG8_BAR; PG8_SCHED;
            PG8_LDB(B0, 1, 0); PG8_LDB(B1, 1, 1); PG8_SCHED; PG8_LDA(At, 1, 0); PG8_STAGE(PG8_SA(0, 1), a2 + hstep, voffA);
            PG8_WAIT_V(8); PG8_WAIT_L(0); PG8_BAR; PG8_MMA(0, 0, At, B0); PG8_MMA(0, 1, At, B1); PG8_BAR; PG8_SCHED;
            PG8_LDA(At, 1, 1); PG8_STAGE(PG8_SB(1, 0), b3, voffB); PG8_STAGE(PG8_SB(1, 1), b3 + hstep, voffB); PG8_STAGE(PG8_SA(1, 0), a3, voffA);
            PG8_WAIT_V(8); PG8_WAIT_L(0); PG8_BAR; PG8_MMA(1, 0, At, B0); PG8_MMA(1, 1, At, B1); PG8_BAR; PG8_SCHED;
            } else {
            PG8_LDB(B0, 0, 0); PG8_SCHED; PG8_LDA(At, 0, 0); PG8_STAGE(PG8_SA(1, 1), a1 + hstep, voffA);
            PG8_WAIT_L(8); PG8_BAR; PG8_WAIT_L(0); PG8_MMA(0, 0, At, B0); PG8_BAR; PG8_SCHED;
            PG8_LDB(B1, 0, 1); PG8_STAGE(PG8_SB(0, 0), b2, voffB);
            PG8_BAR; PG8_WAIT_L(0); PG8_MMA(0, 1, At, B1); PG8_BAR;
            PG8_LDA(At, 0, 1); PG8_STAGE(PG8_SA(0, 0), a2, voffA);
            PG8_BAR; PG8_WAIT_L(0); PG8_MMA(1, 0, At, B0); PG8_BAR; PG8_SCHED;
            PG8_STAGE(PG8_SB(0, 1), b2 + hstep, voffB);
            PG8_WAIT_V(6); PG8_BAR; PG8_MMA(1, 1, At, B1); PG8_BAR;
            PG8_LDB(B0, 1, 0); PG8_SCHED; PG8_LDA(At, 1, 0); PG8_STAGE(PG8_SA(0, 1), a2 + hstep, voffA);
            PG8_WAIT_L(8); PG8_BAR; PG8_WAIT_L(0); PG8_MMA(0, 0, At, B0); PG8_BAR; PG8_SCHED;
            PG8_LDB(B1, 1, 1); PG8_STAGE(PG8_SB(1, 0), b3, voffB);
            PG8_BAR; PG8_WAIT_L(0); PG8_MMA(0, 1, At, B1); PG8_BAR;
            PG8_LDA(At, 1, 1); PG8_STAGE(PG8_SA(1, 0), a3, voffA);
            PG8_BAR; PG8_WAIT_L(0); PG8_MMA(1, 0, At, B0); PG8_BAR; PG8_SCHED;
            PG8_STAGE(PG8_SB(1, 1), b3 + hstep, voffB);
            PG8_WAIT_V(6); PG8_BAR; PG8_MMA(1, 1, At, B1); PG8_BAR;
            }
        }
        if constexpr (ALIGN_EPI) { if (wr == 0) PG8_BAR; }
        if constexpr (!Epi::AFTER_DRAIN) { E(acc, cur, wr, wc, fr, fq); S.done(cur); }
        if (!has_next) break;
#pragma unroll
        for (int a = 0; a < 2; ++a)
#pragma unroll
            for (int b = 0; b < 2; ++b)
#pragma unroll
                for (int m = 0; m < 4; ++m)
#pragma unroll
                    for (int n = 0; n < 2; ++n) acc[a][b][m][n] = (f32x4){0.f, 0.f, 0.f, 0.f};
        cur = nxt; cA = nA; cB = nB; ++ui;
        if constexpr (ALIGN_EPI) { if (wr == 1) PG8_BAR; }
    }
    PG8_WAIT_V(0);
    if constexpr (!ALIGN_EPI) { if (wr == 0) PG8_BAR; }
    PG8_BAR;
    if constexpr (Epi::AFTER_DRAIN) { E.fused(acc, cur, wr, wc, fr, fq, lds, wid, lane); S.done(cur); }
#undef PG8_SA
#undef PG8_SB
#undef PG8_STAGE
#undef PG8_LDA
#undef PG8_LDB
#undef PG8_MMA
#undef PG8_WAIT_V
#undef PG8_WAIT_L
#undef PG8_BAR
#undef PG8_SCHED
}
}

namespace attn {
constexpr int D = 128, NW = 8, QBLK = 32, KVBLK = 64;
constexpr float SCALE = 0.088388347648318440f;
constexpr float THR = 8.f;
#ifndef ATTN_SDEPTH
#define ATTN_SDEPTH 1
#endif
constexpr int SDEPTH = ATTN_SDEPTH;
constexpr int LDQ = 1024, LDK = 512, LDO = 1024;
constexpr size_t SHM_V = KVBLK * D * 2, SHM_K = KVBLK * D * 2, SHM_ATTN = 2 * SHM_V + 2 * SHM_K + NW * 64 * 4;
using bf16 = __hip_bfloat16;
using bf16x8 = __attribute__((ext_vector_type(8))) short;
using s16x4  = __attribute__((ext_vector_type(4))) short;
using f32x16 = __attribute__((ext_vector_type(16))) float;
using f32x8  = __attribute__((ext_vector_type(8))) float;
using u32x4  = __attribute__((ext_vector_type(4))) unsigned;
#define KSWZ(row, colB) ((row) * 256 + ((colB) ^ (((row) & 7) << 4)))
#define SBAR() __builtin_amdgcn_sched_barrier(0)
__device__ __forceinline__ int crow(int r, int hi) { return (r & 3) + 8 * (r >> 2) + 4 * hi; }
typedef float f32x2a __attribute__((ext_vector_type(2))); typedef __bf16 bf16x2a __attribute__((ext_vector_type(2)));
__device__ __forceinline__ unsigned cvtpk(float lo, float hi) { const f32x2a v = {lo, hi}; return __builtin_bit_cast(unsigned, __builtin_convertvector(v, bf16x2a)); }
template <typename TIn> struct Stage;
template <> struct Stage<bf16>  { using T = bf16x8;
  __device__ static __forceinline__ T ld8(const bf16* p) { return *reinterpret_cast<const bf16x8*>(p); }
  __device__ static __forceinline__ bf16x8 tobf(T x) { return x; } };
template <> struct Stage<float> { using T = f32x8;
  __device__ static __forceinline__ T ld8(const float* p) { return *reinterpret_cast<const f32x8*>(p); }
  __device__ static __forceinline__ bf16x8 tobf(T x) {
    u32x4 w = {cvtpk(x[0], x[1]), cvtpk(x[2], x[3]), cvtpk(x[4], x[5]), cvtpk(x[6], x[7])}; return *reinterpret_cast<bf16x8*>(&w); } };

__device__ __forceinline__ void partialSM(f32x16& p0, f32x16& p1, float& m_reg, float& mn, float& alpha) {
  constexpr float C = SCALE * 1.4426950408889634f;
  float pmax = p0[0]; for (int r = 1; r < 16; ++r) pmax = fmaxf(pmax, p0[r]); for (int r = 0; r < 16; ++r) pmax = fmaxf(pmax, p1[r]);
  { auto rr = __builtin_amdgcn_permlane32_swap(__float_as_uint(pmax), __float_as_uint(pmax), false, false);
    pmax = fmaxf(__uint_as_float(rr[0]), __uint_as_float(rr[1])); }
  if (__builtin_expect(__all(pmax - m_reg <= THR / SCALE), 1)) { mn = m_reg; alpha = 1.f; }
  else { mn = fmaxf(m_reg, pmax); alpha = __builtin_amdgcn_exp2f((m_reg - mn) * C); m_reg = mn; }
  float mnC = -mn * C;
  for (int r = 0; r < 16; ++r) p0[r] = fmaf(p0[r], C, mnC); for (int r = 0; r < 16; ++r) p1[r] = fmaf(p1[r], C, mnC);
  for (int r = 0; r < 16; ++r) p0[r] = __builtin_amdgcn_exp2f(p0[r]);
}
__device__ __forceinline__ void finishSM(f32x16& p0, f32x16& p1, float alpha, float& l_reg, bf16x8& pa0, bf16x8& pa1, bf16x8& pa2, bf16x8& pa3) {
  for (int r = 0; r < 16; ++r) p1[r] = __builtin_amdgcn_exp2f(p1[r]);
  float ps = 0; for (int r = 0; r < 16; ++r) ps += p0[r]; for (int r = 0; r < 16; ++r) ps += p1[r];
  { auto rr = __builtin_amdgcn_permlane32_swap(__float_as_uint(ps), __float_as_uint(ps), false, false);
    ps = __uint_as_float(rr[0]) + __uint_as_float(rr[1]); }
  l_reg = l_reg * alpha + ps;
#define PK4(P, BASE, OUT) do { unsigned a0 = cvtpk(P[BASE + 0], P[BASE + 1]), a1 = cvtpk(P[BASE + 2], P[BASE + 3]);   \
    unsigned b0 = cvtpk(P[BASE + 4], P[BASE + 5]), b1 = cvtpk(P[BASE + 6], P[BASE + 7]);                              \
    auto r0 = __builtin_amdgcn_permlane32_swap(a0, b0, false, false); auto r1 = __builtin_amdgcn_permlane32_swap(a1, b1, false, false); \
    u32x4 w = {r0[0], r1[0], r0[1], r1[1]}; OUT = *reinterpret_cast<bf16x8*>(&w); } while (0)
  PK4(p0, 0, pa0); PK4(p0, 8, pa1); PK4(p1, 0, pa2); PK4(p1, 8, pa3);
#undef PK4
}
__device__ __forceinline__ void qkt(f32x16& p0, f32x16& p1, const bf16* Ks, const bf16x8* qr, int r32, int hi) {
  p0 = f32x16{}; p1 = f32x16{};
  for (int d0 = 0; d0 < 8; ++d0) { int cb = (d0 * 16 + hi * 8) * 2;
    bf16x8 b0 = *reinterpret_cast<const bf16x8*>((const char*)Ks + KSWZ(r32, cb));
    bf16x8 b1 = *reinterpret_cast<const bf16x8*>((const char*)Ks + KSWZ(32 + r32, cb));
    p0 = __builtin_amdgcn_mfma_f32_32x32x16_bf16(b0, qr[d0], p0, 0, 0, 0);
    p1 = __builtin_amdgcn_mfma_f32_32x32x16_bf16(b1, qr[d0], p1, 0, 0, 0); }
}
__device__ __forceinline__ int v_st(int k, int c) { const int kk = (k & ~0xC) | ((k & 4) << 1) | ((k & 8) >> 1); return ((kk >> 3) * 4 + (c >> 5)) * 512 + ((kk & 7) * 32 + (c & 31)) * 2; }
__device__ __forceinline__ int v_rd_base(int lane) { return ((lane & 3) << 3) | (((lane >> 2) & 3) << 6) | (((lane >> 4) & 1) << 5) | (((lane >> 5) & 1) << 8); }
constexpr int v_rd_off(int d0, int ks, int half) { return d0 * 512 + ks * 4096 + half * 2048; }
template <int OFF> __device__ __forceinline__ s16x4 tr_read(int vb) {
  s16x4 r; asm volatile("ds_read_b64_tr_b16 %0, %1 offset:%2" : "=&v"(r) : "v"(vb), "i"(OFF) : "memory"); return r;
}
template <int D0> __device__ __forceinline__ void pv_one(f32x16& od, int vb, bf16x8 pa0, bf16x8 pa1, bf16x8 pa2, bf16x8 pa3) {
  const s16x4 l0 = tr_read<v_rd_off(D0, 0, 0)>(vb), h0 = tr_read<v_rd_off(D0, 0, 1)>(vb), l1 = tr_read<v_rd_off(D0, 1, 0)>(vb), h1 = tr_read<v_rd_off(D0, 1, 1)>(vb);
  const s16x4 l2 = tr_read<v_rd_off(D0, 2, 0)>(vb), h2 = tr_read<v_rd_off(D0, 2, 1)>(vb), l3 = tr_read<v_rd_off(D0, 3, 0)>(vb), h3 = tr_read<v_rd_off(D0, 3, 1)>(vb);
  asm volatile("s_waitcnt lgkmcnt(0)" ::: "memory"); SBAR();
#define PK(L, H) (bf16x8){L[0], L[1], L[2], L[3], H[0], H[1], H[2], H[3]}
  od = __builtin_amdgcn_mfma_f32_32x32x16_bf16(pa0, PK(l0, h0), od, 0, 0, 0);
  od = __builtin_amdgcn_mfma_f32_32x32x16_bf16(pa1, PK(l1, h1), od, 0, 0, 0);
  od = __builtin_amdgcn_mfma_f32_32x32x16_bf16(pa2, PK(l2, h2), od, 0, 0, 0);
  od = __builtin_amdgcn_mfma_f32_32x32x16_bf16(pa3, PK(l3, h3), od, 0, 0, 0);
#undef PK
}
__device__ __forceinline__ void pv_d0(f32x16* o, int vb, bf16x8 pa0, bf16x8 pa1, bf16x8 pa2, bf16x8 pa3) {
  pv_one<0>(o[0], vb, pa0, pa1, pa2, pa3); pv_one<1>(o[1], vb, pa0, pa1, pa2, pa3); pv_one<2>(o[2], vb, pa0, pa1, pa2, pa3); pv_one<3>(o[3], vb, pa0, pa1, pa2, pa3);
}


__device__ __forceinline__ void attn_unit(const bfu* Qb, const bfu* __restrict__ Kh_, const bfu* __restrict__ Vh_, bfu* Ob,
                                          int t0, const float* __restrict__ qnorm, const float* __restrict__ tabc, const float* __restrict__ tabs, int seq, char* lds, const int tid) {
  const bf16* Kh = (const bf16*)Kh_; const bf16* Vh = (const bf16*)Vh_;
  using St = Stage<bf16>;
  const int wid = tid >> 6, lane = tid & 63, r32 = lane & 31, hi = lane >> 5;
  bf16* V_lds = (bf16*)lds; bf16* K_lds = (bf16*)(lds + 2 * SHM_V);
  float* ws = (float*)(lds + 2 * SHM_V + 2 * SHM_K) + wid * 64; float* li_l = ws; float* al_l = ws + 32;
  float m_reg = -1e30f, l_reg = 0; f32x16 o[4] = {}; bf16x8 qr[8];
#if DIAG == 3 || DIAG == 4
  { const bfu* Qw = Qb + (long)(wid * QBLK + r32) * LDQ + hi * 8;
#pragma unroll
    for (int d0 = 0; d0 < 8; ++d0) qr[d0] = *reinterpret_cast<const bf16x8*>(Qw + d0 * 16); }
#else
  {
    const bfu* Qw = Qb + (long)(wid * QBLK + r32) * LDQ + hi * 8;
    float qf[8][8]; float ss = 0.f;
#pragma unroll
    for (int d0 = 0; d0 < 8; ++d0) { const u32x4 w = *reinterpret_cast<const u32x4*>(Qw + d0 * 16);
#pragma unroll
      for (int j = 0; j < 4; ++j) { const float a = __builtin_bit_cast(float, w[j] << 16), b = __builtin_bit_cast(float, w[j] & 0xffff0000u); qf[d0][2 * j] = a; qf[d0][2 * j + 1] = b; ss += a * a + b * b; } }
    { auto rr = __builtin_amdgcn_permlane32_swap(__float_as_uint(ss), __float_as_uint(ss), false, false); ss = __uint_as_float(rr[0]) + __uint_as_float(rr[1]); }
    const float rstd = 1.0f / sqrtf(ss * (1.0f / 128.0f) + 1e-6f);
#pragma unroll
    for (int d0 = 0; d0 < 8; ++d0) { const float4 g0 = *reinterpret_cast<const float4*>(qnorm + d0 * 16 + hi * 8), g1 = *reinterpret_cast<const float4*>(qnorm + d0 * 16 + hi * 8 + 4);
      qf[d0][0] *= rstd * g0.x; qf[d0][1] *= rstd * g0.y; qf[d0][2] *= rstd * g0.z; qf[d0][3] *= rstd * g0.w; qf[d0][4] *= rstd * g1.x; qf[d0][5] *= rstd * g1.y; qf[d0][6] *= rstd * g1.z; qf[d0][7] *= rstd * g1.w; }
    const int t = t0 + wid * QBLK + r32, prow = t >> 6, pcol = t & 63;
#pragma unroll
    for (int a = 0; a < 2; ++a) { const int pos = a ? pcol : prow;
#pragma unroll
      for (int dp = 0; dp < 2; ++dp) { const int i0 = pos * 32 + dp * 16 + hi * 8;
#pragma unroll
        for (int j = 0; j < 8; ++j) { const float c = tabc[i0 + j], s = tabs[i0 + j]; const float x1 = qf[4 * a + dp][j], x2 = qf[4 * a + dp + 2][j];
          qf[4 * a + dp][j] = x1 * c - x2 * s; qf[4 * a + dp + 2][j] = x2 * c + x1 * s; } } }
#pragma unroll
    for (int d0 = 0; d0 < 8; ++d0) { u32x4 w = {cvtpk(qf[d0][0], qf[d0][1]), cvtpk(qf[d0][2], qf[d0][3]), cvtpk(qf[d0][4], qf[d0][5]), cvtpk(qf[d0][6], qf[d0][7])}; qr[d0] = *reinterpret_cast<bf16x8*>(&w); }
  }
#endif
  const int sr = tid >> 4, sc = (tid & 15) * 8, vst0 = v_st(sr, sc), vst1 = v_st(32 + sr, sc);
  const int vb0 = (int)(uintptr_t)V_lds + v_rd_base(lane);
  struct { typename St::T vs0, vs1, ks0, ks1; } sr_[SDEPTH];
#define SLOAD(i, k0) do { sr_[i].vs0 = St::ld8(&Vh[(long)((k0) + sr) * LDK + sc]); sr_[i].vs1 = St::ld8(&Vh[(long)((k0) + 32 + sr) * LDK + sc]); \
    sr_[i].ks0 = St::ld8(&Kh[(long)((k0) + sr) * LDK + sc]); sr_[i].ks1 = St::ld8(&Kh[(long)((k0) + 32 + sr) * LDK + sc]); } while (0)
#define SWRITE(b, i) do { *(bf16x8*)((char*)V_lds + (b) * SHM_V + vst0) = St::tobf(sr_[i].vs0);          \
    *(bf16x8*)((char*)V_lds + (b) * SHM_V + vst1) = St::tobf(sr_[i].vs1); int kc = sc * 2;               \
    *(bf16x8*)((char*)K_lds + (b) * SHM_K + KSWZ(sr, kc)) = St::tobf(sr_[i].ks0);                       \
    *(bf16x8*)((char*)K_lds + (b) * SHM_K + KSWZ(32 + sr, kc)) = St::tobf(sr_[i].ks1); } while (0)
#define SWAIT() do { if constexpr (SDEPTH == 2) asm volatile("s_waitcnt vmcnt(4)" ::: "memory"); else asm volatile("s_waitcnt vmcnt(0)" ::: "memory"); } while (0)
#define RESC(a) do { if (__any((a) < 1.f)) { if (hi == 0) al_l[r32] = (a); asm volatile("s_waitcnt lgkmcnt(0)" ::: "memory"); \
    for (int d = 0; d < 4; ++d) for (int r = 0; r < 16; ++r) o[d][r] *= al_l[crow(r, hi)]; } } while (0)
  f32x16 pA0, pA1, pB0, pB1; float mnA, mnB, alA, alB; bf16x8 pa0, pa1, pa2, pa3; const int NT = seq / KVBLK;
  constexpr int SE = 0, SO = SDEPTH - 1;
  SLOAD(SE, 0); asm volatile("s_waitcnt vmcnt(0)" ::: "memory"); SWRITE(0, SE); __syncthreads();
  qkt(pA0, pA1, K_lds, qr, r32, hi); partialSM(pA0, pA1, m_reg, mnA, alA);
  SLOAD(SO, KVBLK); if constexpr (SDEPTH == 2) { if (2 < NT) SLOAD(SE, 2 * KVBLK); }
  SWAIT(); SWRITE(1, SO); __syncthreads();
  for (int j = 1; j + 1 < NT; j += 2) {
    SBAR(); qkt(pB0, pB1, (bf16*)((char*)K_lds + SHM_K), qr, r32, hi);
    finishSM(pA0, pA1, alA, l_reg, pa0, pa1, pa2, pa3); SBAR();
    SLOAD(SO, (j + SDEPTH) * KVBLK); SBAR();
    pv_d0(o, vb0, pa0, pa1, pa2, pa3); partialSM(pB0, pB1, m_reg, mnB, alB);
    __syncthreads(); SWAIT(); SWRITE(0, SE);
    RESC(alB); __syncthreads();
    SBAR(); qkt(pA0, pA1, K_lds, qr, r32, hi);
    finishSM(pB0, pB1, alB, l_reg, pa0, pa1, pa2, pa3); SBAR();
    if (SDEPTH == 1 || j + 3 < NT) SLOAD(SE, (j + 1 + SDEPTH) * KVBLK); SBAR();
    pv_d0(o, vb0 + (int)SHM_V, pa0, pa1, pa2, pa3); partialSM(pA0, pA1, m_reg, mnA, alA);
    __syncthreads(); SWAIT(); SWRITE(1, SO);
    RESC(alA); __syncthreads();
  }
  SBAR(); qkt(pB0, pB1, (bf16*)((char*)K_lds + SHM_K), qr, r32, hi);
  finishSM(pA0, pA1, alA, l_reg, pa0, pa1, pa2, pa3); SBAR();
  pv_d0(o, vb0, pa0, pa1, pa2, pa3); partialSM(pB0, pB1, m_reg, mnB, alB);
  __syncthreads(); RESC(alB);
  finishSM(pB0, pB1, alB, l_reg, pa0, pa1, pa2, pa3); SBAR();
  pv_d0(o, vb0 + (int)SHM_V, pa0, pa1, pa2, pa3);
  if (hi == 0) li_l[r32] = l_reg; asm volatile("s_waitcnt lgkmcnt(0)" ::: "memory");
  float rli[16];
#pragma unroll
  for (int r = 0; r < 16; ++r) rli[r] = __builtin_amdgcn_rcpf(li_l[crow(r, hi)]);
  __syncthreads();
  { int et = tid; asm volatile("" : "+v"(et));
    const int ln = et & 63, ewid = et >> 6, er32 = ln & 31, ehi = ln >> 5;
    bfu* stg = (bfu*)lds + ewid * 4096; bfu* sw = stg + (4 * ehi) * 128 + er32;
#pragma unroll
    for (int r = 0; r < 16; ++r) { const int ro = (r & 3) + 8 * (r >> 2);
#pragma unroll
      for (int d0 = 0; d0 < 4; ++d0) sw[ro * 128 + d0 * 32] = (bfu)f2bf(o[d0][r] * rli[r]); }
    asm volatile("s_waitcnt lgkmcnt(0)" ::: "memory");
    const bfu* sp = stg + (ln >> 4) * 128 + (ln & 15) * 8;
    bfu* Ow = Ob + (long)(ewid * QBLK + (ln >> 4)) * LDO + (ln & 15) * 8;
#pragma unroll
    for (int i = 0; i < 8; ++i) { const u32x4 v = *(const u32x4*)(sp + i * 512); *(u32x4*)(Ow + (long)i * 4 * LDO) = v; }
  }
  __syncthreads();
#undef SLOAD
#undef SWRITE
#undef SWAIT
#undef RESC
}
#undef SBAR
#undef KSWZ
}
#define XB_TMO      128
#define XB_XCNT(j)  (256  + 64 * (j))
#define XB_XSUB(j)  (1280 + 64 * (j))
#define XB_XGEN(j)  (2304 + 64 * (j))
#define XB_TOP      3328
#define XB_TOPGEN   3392
#define XCD_BAR_WORDS 3456
#define XB_SPIN_CAP (1u << 18)

__device__ __forceinline__ unsigned xb_ld(unsigned* p)              { return __hip_atomic_load(p, __ATOMIC_RELAXED, __HIP_MEMORY_SCOPE_AGENT); }
__device__ __forceinline__ unsigned xb_add(unsigned* p, unsigned v) { return __hip_atomic_fetch_add(p, v, __ATOMIC_RELAXED, __HIP_MEMORY_SCOPE_AGENT); }
__device__ __forceinline__ unsigned xb_xcc_id() { return (unsigned)__builtin_amdgcn_s_getreg((3 << 11) | 20) & 0xFu; }
#define XB_SPIN(cond, bar) do { unsigned _sp = 0; while (cond) { __builtin_amdgcn_s_sleep(1); \
    if ((++_sp & 255u) == 0u) { if (xb_ld(&(bar)[XB_TMO])) break; if (_sp > XB_SPIN_CAP) { atomicAdd(&(bar)[XB_TMO], 1u); break; } } } } while (0)

struct XcdBarrier {
    unsigned* bar; unsigned x;
    volatile LAS unsigned* st;
};

__device__ __forceinline__ XcdBarrier xcd_barrier_post(unsigned* bar, volatile LAS unsigned* st) {
    XcdBarrier b; b.bar = bar; b.x = xb_xcc_id(); b.st = st;
    if (threadIdx.x == 0) (void)xb_add(&bar[XB_XCNT(b.x)], 1u);
    return b;
}
__device__ __forceinline__ void xcd_barrier_complete(unsigned* bar, unsigned x, unsigned& nloc, unsigned& nx) {
    const unsigned G = gridDim.x * gridDim.y * gridDim.z;
    unsigned sum, cnt, mine, sp = 0u;
    for (;;) {
        sum = 0u; cnt = 0u; mine = 0u;
#pragma unroll
        for (unsigned j = 0; j < 16; ++j) { const unsigned c = xb_ld(&bar[XB_XCNT(j)]); sum += c; cnt += (c > 0u) ? 1u : 0u; mine = (j == x) ? c : mine; }
        if (sum == G) break;
        __builtin_amdgcn_s_sleep(1);
        if ((++sp & 255u) == 0u) { if (xb_ld(&bar[XB_TMO])) break; if (sp > XB_SPIN_CAP) { atomicAdd(&bar[XB_TMO], 1u); break; } }
    }
    nloc = mine > 0u ? mine : 1u; nx = cnt > 0u ? cnt : 1u;
}

__device__ __forceinline__ void xcd_barrier(const XcdBarrier& b) {
    asm volatile("s_waitcnt vmcnt(0)" ::: "memory");
    __syncthreads();
    if (threadIdx.x == 0) {
        unsigned* bar = b.bar;
        __builtin_amdgcn_s_waitcnt(0);
        unsigned nloc = b.st[0], nx = b.st[1];
        if (nloc == 0u) { xcd_barrier_complete(bar, b.x, nloc, nx); b.st[0] = nloc; b.st[1] = nx; }
        const unsigned old = xb_add(&bar[XB_XSUB(b.x)], 1u);
        const unsigned gen = old / nloc;
        if (old + 1u == (gen + 1u) * nloc) {
            __builtin_amdgcn_fence(__ATOMIC_RELEASE, "agent");
            asm volatile("s_waitcnt vmcnt(0)" ::: "memory");
            const unsigned og = xb_add(&bar[XB_TOP], 1u);
            const unsigned tg = og / nx;
            if (og + 1u == (tg + 1u) * nx) xb_add(&bar[XB_TOPGEN], 1u);
            else XB_SPIN(xb_ld(&bar[XB_TOPGEN]) == tg, bar);
            __builtin_amdgcn_fence(__ATOMIC_ACQUIRE, "agent");
            xb_add(&bar[XB_XGEN(b.x)], 1u);
            asm volatile("s_waitcnt vmcnt(0)" ::: "memory");
        } else {
            XB_SPIN(xb_ld(&bar[XB_XGEN(b.x)]) == gen, bar);
            __builtin_amdgcn_fence(__ATOMIC_ACQUIRE, "agent");
            asm volatile("s_waitcnt vmcnt(0)" ::: "memory");
        }
    }
    __syncthreads();
}

namespace gla {
typedef short bf16x8 __attribute__((ext_vector_type(8)));
typedef short s16x4 __attribute__((ext_vector_type(4)));
typedef float f32x4 __attribute__((ext_vector_type(4)));
typedef unsigned u32x4 __attribute__((ext_vector_type(4)));
typedef unsigned u32x2 __attribute__((ext_vector_type(2)));
typedef short v4i16_t __attribute__((ext_vector_type(4)));
constexpr int QT_STR = 272, V_STR = 544, S_STR = 144, O_STR = 1040;
constexpr int L_LA = 0, L_QT = 32768, L_KT = L_QT + 64 * QT_STR, L_O = 0, L_V = L_KT + 64 * QT_STR, L_S = L_V + 64 * V_STR, L_GR = L_S + 64 * S_STR, L_EL = L_GR + 4096, L_QS = L_EL + 512, L_END = L_QS + 2048;
static_assert(64 * O_STR <= L_V && L_END <= 131072, "gla lds map");
__device__ __forceinline__ unsigned pk(float lo, float hi) { typedef float f2 __attribute__((ext_vector_type(2))); typedef __bf16 b2 __attribute__((ext_vector_type(2))); const f2 v = {lo, hi}; return __builtin_bit_cast(unsigned, __builtin_convertvector(v, b2)); }
__device__ __forceinline__ s16x4 trr(LAS const unsigned char* p) { return __builtin_bit_cast(s16x4, __builtin_amdgcn_ds_read_tr16_b64_v4i16((LAS v4i16_t*)p)); }
#define GLA_BAR() __syncthreads()

struct Io {
    const float* GR; const bfu* GQK; const bfu* GV; const float* wgk; const float* bgk;
    float* ST; float* TOT;
    bfu* OF; const bfu* UA; const bfu* SG; bfu* AQ; const float* gnorm;
};

template <int MODE>
__device__ __forceinline__ void pass(LAS unsigned char* lds, const Io& io, int b, int h, int seg, int dir, int tid) {
    const int lane = tid & 63, wave = __builtin_amdgcn_readfirstlane(tid >> 6), li = lane & 15, g = lane >> 4;
    const int d = tid & 127, rq = tid >> 7;
    float w[16]; float bias;
#pragma unroll
    for (int j = 0; j < 16; ++j) w[j] = io.wgk[j * 512 + h * 128 + d];
    bias = io.bgk[h * 128 + d];
    f32x4 st[8][2];
    if (MODE == 0) {
#pragma unroll
        for (int t = 0; t < 16; ++t) st[t >> 1][t & 1] = (f32x4){0.f, 0.f, 0.f, 0.f};
    } else {
#pragma unroll
        for (int t = 0; t < 16; ++t)
#pragma unroll
            for (int r = 0; r < 4; ++r) st[t >> 1][t & 1][r] = io.ST[((wave * 16 + t) * 4 + r) * 64 + lane];
    }
    float tot = 0.f;
    const size_t seg0 = (size_t)b * SEQ + (size_t)seg * 256;
    for (int cc = 0; cc < 4; ++cc) {
        const int c = dir ? 3 - cc : cc; const size_t tok0 = seg0 + c * 64;
        u32x4 qv[2], kv[2], vv[4];
#pragma unroll
        for (int i = 0; i < 2; ++i) { const int p = tid + 512 * i, r = p >> 4, d0 = (p & 15) * 8; const size_t t = tok0 + (dir ? 63 - r : r);
            qv[i] = *(const u32x4*)(io.GQK + t * 1024 + h * 128 + d0); kv[i] = *(const u32x4*)(io.GQK + t * 1024 + 512 + h * 128 + d0); }
#pragma unroll
        for (int i = 0; i < 4; ++i) { const int p = tid + 512 * i, r = p >> 5, c0 = (p & 31) * 8; const size_t t = tok0 + (dir ? 63 - r : r);
            vv[i] = *(const u32x4*)(io.GV + t * 1024 + h * 256 + c0); }
        if (tid < 256) { const int r = tid >> 2, j4 = (tid & 3) * 4; const size_t t = tok0 + (dir ? 63 - r : r);
            *(LAS f32x4*)(lds + L_GR + r * 64 + j4 * 4) = *(const f32x4*)(io.GR + t * 32 + dir * 16 + j4); }
        GLA_BAR();
        float la[16]; float run = 0.f;
#pragma unroll
        for (int i = 0; i < 16; ++i) { const int r = rq * 16 + i; float x = bias;
            const f32x4 g0 = *(LAS const f32x4*)(lds + L_GR + r * 64), g1 = *(LAS const f32x4*)(lds + L_GR + r * 64 + 16), g2 = *(LAS const f32x4*)(lds + L_GR + r * 64 + 32), g3 = *(LAS const f32x4*)(lds + L_GR + r * 64 + 48);
            x += g0[0] * w[0] + g0[1] * w[1] + g0[2] * w[2] + g0[3] * w[3] + g1[0] * w[4] + g1[1] * w[5] + g1[2] * w[6] + g1[3] * w[7]
               + g2[0] * w[8] + g2[1] * w[9] + g2[2] * w[10] + g2[3] * w[11] + g3[0] * w[12] + g3[1] * w[13] + g3[2] * w[14] + g3[3] * w[15];
            const float e = __builtin_amdgcn_exp2f(-1.4426950408889634f * fabsf(x));
            const float ls = -(fmaxf(-x, 0.f) + 0.6931471805599453f * __builtin_amdgcn_logf(1.0f + e)) * 0.0625f;
            run += ls; la[i] = run; }
        *(LAS float*)(lds + L_QS + (rq * 128 + d) * 4) = run;
        GLA_BAR();
        { float off = 0.f;
#pragma unroll
          for (int q = 0; q < 3; ++q) { const float tq = *(LAS const float*)(lds + L_QS + (q * 128 + d) * 4); off += (q < rq) ? tq : 0.f; }
#pragma unroll
          for (int i = 0; i < 16; ++i) *(LAS float*)(lds + L_LA + ((rq * 16 + i) * 128 + d) * 4) = la[i] + off;
          if (rq == 3) { const float last = la[15] + off; *(LAS float*)(lds + L_EL + d * 4) = __builtin_amdgcn_exp2f(1.4426950408889634f * last); tot += last; } }
        GLA_BAR();
#pragma unroll
        for (int i = 0; i < 2; ++i) { const int p = tid + 512 * i, r = p >> 4, d0 = (p & 15) * 8;
            const f32x4 c0 = *(LAS const f32x4*)(lds + L_LA + (r * 128 + d0) * 4), c1 = *(LAS const f32x4*)(lds + L_LA + (r * 128 + d0 + 4) * 4);
            float e[8], ei[8];
#pragma unroll
            for (int j = 0; j < 4; ++j) { e[j] = __builtin_amdgcn_exp2f(1.4426950408889634f * c0[j]); e[4 + j] = __builtin_amdgcn_exp2f(1.4426950408889634f * c1[j]);
                ei[j] = __builtin_amdgcn_exp2f(-1.4426950408889634f * c0[j]); ei[4 + j] = __builtin_amdgcn_exp2f(-1.4426950408889634f * c1[j]); }
            u32x4 qo, ko;
#pragma unroll
            for (int j = 0; j < 4; ++j) { qo[j] = pk(bflo(qv[i][j]) * e[2 * j], bfhi(qv[i][j]) * e[2 * j + 1]); ko[j] = pk(bflo(kv[i][j]) * ei[2 * j], bfhi(kv[i][j]) * ei[2 * j + 1]); }
            if (MODE != 0) *(LAS u32x4*)(lds + L_QT + r * QT_STR + d0 * 2) = qo;
            *(LAS u32x4*)(lds + L_KT + r * QT_STR + d0 * 2) = ko; }
#pragma unroll
        for (int i = 0; i < 4; ++i) { const int p = tid + 512 * i, r = p >> 5, c0 = (p & 31) * 8; *(LAS u32x4*)(lds + L_V + r * V_STR + c0 * 2) = vv[i]; }
        GLA_BAR();
        f32x4 acc[4][2];
        if (MODE != 0) {
            const int ti = wave >> 1;
#pragma unroll
            for (int jj = 0; jj < 2; ++jj) { const int tj = 2 * (wave & 1) + jj; f32x4 s = {0.f, 0.f, 0.f, 0.f};
                if (tj <= ti) {
#pragma unroll
                    for (int ks = 0; ks < 4; ++ks) { const bf16x8 a = *(LAS const bf16x8*)(lds + L_QT + (16 * ti + li) * QT_STR + ks * 64 + g * 16), bb = *(LAS const bf16x8*)(lds + L_KT + (16 * tj + li) * QT_STR + ks * 64 + g * 16);
                        s = __builtin_amdgcn_mfma_f32_16x16x32_bf16(a, bb, s, 0, 0, 0); } }
#pragma unroll
                for (int r = 0; r < 4; ++r) { const int ig = 16 * ti + 4 * g + r, jg = 16 * tj + li; const bool keep = dir ? (ig > jg) : (ig >= jg);
                    *(LAS unsigned short*)(lds + L_S + ig * S_STR + jg * 2) = (unsigned short)(pk(keep ? s[r] : 0.f, 0.f) & 0xffffu); } }
            GLA_BAR();
        }
        bf16x8 bv[2][2];
#pragma unroll
        for (int ks = 0; ks < 2; ++ks)
#pragma unroll
            for (int tc = 0; tc < 2; ++tc) { const LAS unsigned char* p = lds + L_V + (32 * ks + 8 * g + (li >> 2)) * V_STR + (wave * 32 + 16 * tc + 4 * (li & 3)) * 2;
                const s16x4 lo = trr(p), hi = trr(p + 4 * V_STR); bv[ks][tc] = (bf16x8){lo[0], lo[1], lo[2], lo[3], hi[0], hi[1], hi[2], hi[3]}; }
        if (MODE != 0) {
#pragma unroll
            for (int mi = 0; mi < 4; ++mi) { acc[mi][0] = (f32x4){0.f, 0.f, 0.f, 0.f}; acc[mi][1] = (f32x4){0.f, 0.f, 0.f, 0.f}; }
#pragma unroll
            for (int ks = 0; ks < 2; ++ks)
#pragma unroll
                for (int mi = 0; mi < 4; ++mi) { const bf16x8 a = *(LAS const bf16x8*)(lds + L_S + (16 * mi + li) * S_STR + ks * 64 + g * 16);
                    acc[mi][0] = __builtin_amdgcn_mfma_f32_16x16x32_bf16(a, bv[ks][0], acc[mi][0], 0, 0, 0); acc[mi][1] = __builtin_amdgcn_mfma_f32_16x16x32_bf16(a, bv[ks][1], acc[mi][1], 0, 0, 0); }
#pragma unroll
            for (int ks = 0; ks < 4; ++ks) { bf16x8 bs[2];
#pragma unroll
                for (int tc = 0; tc < 2; ++tc) { u32x4 u; u[0] = pk(st[2 * ks][tc][0], st[2 * ks][tc][1]); u[1] = pk(st[2 * ks][tc][2], st[2 * ks][tc][3]); u[2] = pk(st[2 * ks + 1][tc][0], st[2 * ks + 1][tc][1]); u[3] = pk(st[2 * ks + 1][tc][2], st[2 * ks + 1][tc][3]); bs[tc] = __builtin_bit_cast(bf16x8, u); }
#pragma unroll
                for (int mi = 0; mi < 4; ++mi) { const u32x2 a0 = *(LAS const u32x2*)(lds + L_QT + (16 * mi + li) * QT_STR + (32 * ks + 4 * g) * 2), a1 = *(LAS const u32x2*)(lds + L_QT + (16 * mi + li) * QT_STR + (32 * ks + 16 + 4 * g) * 2);
                    const u32x4 au = {a0[0], a0[1], a1[0], a1[1]}; const bf16x8 a = __builtin_bit_cast(bf16x8, au);
                    acc[mi][0] = __builtin_amdgcn_mfma_f32_16x16x32_bf16(a, bs[0], acc[mi][0], 0, 0, 0); acc[mi][1] = __builtin_amdgcn_mfma_f32_16x16x32_bf16(a, bs[1], acc[mi][1], 0, 0, 0); } }
        }
#pragma unroll
        for (int ks = 0; ks < 2; ++ks)
#pragma unroll
            for (int tr = 0; tr < 8; ++tr) { const LAS unsigned char* p = lds + L_KT + (32 * ks + 8 * g + (li >> 2)) * QT_STR + (16 * tr + 4 * (li & 3)) * 2;
                const s16x4 lo = trr(p), hi = trr(p + 4 * QT_STR); const bf16x8 a = (bf16x8){lo[0], lo[1], lo[2], lo[3], hi[0], hi[1], hi[2], hi[3]};
                st[tr][0] = __builtin_amdgcn_mfma_f32_16x16x32_bf16(a, bv[ks][0], st[tr][0], 0, 0, 0); st[tr][1] = __builtin_amdgcn_mfma_f32_16x16x32_bf16(a, bv[ks][1], st[tr][1], 0, 0, 0); }
#pragma unroll
        for (int tr = 0; tr < 8; ++tr) { const f32x4 el = *(LAS const f32x4*)(lds + L_EL + (16 * tr + 4 * g) * 4); st[tr][0] *= el; st[tr][1] *= el; }
        if (MODE != 0) {
            GLA_BAR();
#pragma unroll
            for (int mi = 0; mi < 4; ++mi)
#pragma unroll
                for (int tc = 0; tc < 2; ++tc)
#pragma unroll
                    for (int r = 0; r < 4; ++r) *(LAS float*)(lds + L_O + (16 * mi + 4 * g + r) * O_STR + (wave * 32 + 16 * tc + li) * 4) = acc[mi][tc][r];
            GLA_BAR();
            if (MODE == 1) {
#pragma unroll
                for (int i = 0; i < 4; ++i) { const int p = tid + 512 * i, r = p >> 5, c0 = (p & 31) * 8; const size_t t = tok0 + (dir ? 63 - r : r);
                    const f32x4 o0 = *(LAS const f32x4*)(lds + L_O + r * O_STR + c0 * 4), o1 = *(LAS const f32x4*)(lds + L_O + r * O_STR + c0 * 4 + 16);
                    const u32x4 u = {pk(o0[0], o0[1]), pk(o0[2], o0[3]), pk(o1[0], o1[1]), pk(o1[2], o1[3])}; *(u32x4*)(io.OF + t * 1024 + h * 256 + c0) = u; }
            } else {
                const f32x4 gn = *(const f32x4*)(io.gnorm + 4 * lane);
#pragma unroll
                for (int i = 0; i < 8; ++i) { const int r = wave * 8 + i; const size_t t = tok0 + (dir ? 63 - r : r), base = t * 1024 + h * 256 + 4 * lane;
                    f32x4 o = *(LAS const f32x4*)(lds + L_O + r * O_STR + lane * 16);
                    const u32x2 f = *(const u32x2*)(io.OF + base), ua = *(const u32x2*)(io.UA + base), sg = *(const u32x2*)(io.SG + base), mb = *(const u32x2*)(io.AQ + base);
                    o[0] += bflo(f[0]); o[1] += bfhi(f[0]); o[2] += bflo(f[1]); o[3] += bfhi(f[1]);
                    const float rstd = 1.0f / sqrtf(wave_sum((o[0] * o[0] + o[1] * o[1]) + (o[2] * o[2] + o[3] * o[3])) * (1.f / 256.f) + 1e-6f);
                    u32x2 wv; wv[0] = pk(o[0] * rstd * gn[0] * bflo(ua[0]) + bflo(mb[0]) * bflo(sg[0]), o[1] * rstd * gn[1] * bfhi(ua[0]) + bfhi(mb[0]) * bfhi(sg[0]));
                    wv[1] = pk(o[2] * rstd * gn[2] * bflo(ua[1]) + bflo(mb[1]) * bflo(sg[1]), o[3] * rstd * gn[3] * bfhi(ua[1]) + bfhi(mb[1]) * bfhi(sg[1]));
                    *(u32x2*)(io.AQ + base) = wv; }
            }
        }
    }
    if (MODE == 0) {
#pragma unroll
        for (int t = 0; t < 16; ++t)
#pragma unroll
            for (int r = 0; r < 4; ++r) io.ST[((wave * 16 + t) * 4 + r) * 64 + lane] = st[t >> 1][t & 1][r];
        if (rq == 3) io.TOT[d] = tot;
    }
    GLA_BAR();
}
}

__device__ __forceinline__ int fresh_tid(int wave_s) { int l; asm volatile("v_mbcnt_lo_u32_b32 %0, -1, 0\n\tv_mbcnt_hi_u32_b32 %0, -1, %0" : "=v"(l)); return wave_s * 64 + l; }
#define PHASE_IDS const int tid_ = fresh_tid(C.wave_s); const int lane_ = tid_ & 63; const int wave_ = __builtin_amdgcn_readfirstlane(tid_ >> 6); (void)lane_; (void)wave_
struct Ctx {
    LAS unsigned char* lds; char* ldsg; int vcu, G, wave_s;
    const float *x, *mix_norm, *w_in, *wgk_f, *bgk_f, *wgk_b, *bgk_b, *gla_norm, *q_norm, *k_norm, *b_gate, *w_o, *ffn_norm, *w_gu, *w_dn, *final_norm;
    float* out; unsigned char* ws;
};
#define WSP(T, off) ((T*)(C.ws + (off)))

__device__ __forceinline__ int src_col_in(int rho0) {
    const int tile = rho0 >> 8, c = rho0 & 255;
    if (tile < 8) return rho0;
    if (tile < 16) { const int u = tile - 8; return c < 128 ? 2048 + 128 * u + c : 4640 + 128 * u + (c - 128); }
    if (tile < 20) return 3104 + (tile - 16) * 256 + c;
    if (tile == 20) return 4128 + c;
    if (tile == 21) return 4384 + c;
    if (tile < 26) return 5664 + (tile - 22) * 256 + c;
    return c < 32 ? 3072 + c : -1;
}
__device__ __forceinline__ int src_col_gu(int rho0) { const int tile = rho0 >> 8, c = rho0 & 255; return c < 128 ? 128 * tile + c : 2816 + 128 * tile + (c - 128); }
__device__ __forceinline__ void p0_transpose_item(const float* W, int K, int N, bfu* WT, int dr0, int sc0, int k0, const float* g, LAS float* scr, int lane) {
    if (sc0 >= 0) {
#pragma unroll 8
        for (int i = 0; i < 32; ++i) { const int kk = 2 * i + (lane >> 5); float v = W[(size_t)(k0 + kk) * N + sc0 + (lane & 31)]; if (g) v *= g[k0 + kk]; scr[kk * 33 + (lane & 31)] = v; }
    } else {
#pragma unroll 8
        for (int i = 0; i < 32; ++i) { const int kk = 2 * i + (lane >> 5); scr[kk * 33 + (lane & 31)] = 0.f; }
    }
    LDS_WAIT(); asm volatile("" ::: "memory");
    const int c = lane & 7;
#pragma unroll
    for (int j = 0; j < 4; ++j) { const int n = (lane >> 3) + 8 * j; const LAS float* s = scr + (8 * c) * 33 + n;
        v4u o; o.x = pk2(s[0 * 33], s[1 * 33]); o.y = pk2(s[2 * 33], s[3 * 33]); o.z = pk2(s[4 * 33], s[5 * 33]); o.w = pk2(s[6 * 33], s[7 * 33]);
        *(GAS v4u*)(WT + (size_t)(dr0 + n) * K + k0 + 8 * c) = o; }
    LDS_WAIT(); asm volatile("" ::: "memory");
}
__device__ __forceinline__ void phase_prologue(const Ctx& C) {
    PHASE_IDS;
    LAS float* scr = (LAS float*)(C.lds + wave_ * 16384);
    const int gw = C.vcu * NWAVES + wave_, NGW = C.G * NWAVES;
    constexpr int I_IN = 16 * (NIN / 32), I_O = 16 * 32, I_GU = 16 * (2 * DFF / 32), I_DN = (DFF / 64) * 32;
    for (int it = gw; it < I_IN + I_O + I_GU + I_DN; it += NGW) {
        int r = it;
        if (r < I_IN) { const int kb = r / (NIN / 32), nb = r % (NIN / 32); p0_transpose_item(C.w_in, DM, DIN, WSP(bfu, WS_WIN), nb * 32, src_col_in(nb * 32), kb * 64, nullptr, scr, lane_); continue; } r -= I_IN;
        if (r < I_O) { const int kb = r / 32, nb = r % 32; p0_transpose_item(C.w_o, DM, DM, WSP(bfu, WS_WO), nb * 32, nb * 32, kb * 64, nullptr, scr, lane_); continue; } r -= I_O;
        if (r < I_GU) { const int kb = r / (2 * DFF / 32), nb = r % (2 * DFF / 32); p0_transpose_item(C.w_gu, DM, 2 * DFF, WSP(bfu, WS_WGU), nb * 32, src_col_gu(nb * 32), kb * 64, C.ffn_norm, scr, lane_); continue; } r -= I_GU;
        { const int kb = r / 32, nb = r % 32; p0_transpose_item(C.w_dn, DFF, DM, WSP(bfu, WS_WDN), nb * 32, nb * 32, kb * 64, nullptr, scr, lane_); }
    }
    bfu* H = (bfu*)C.out;
    for (int m = gw; m < TOK; m += NGW) {
        const float4* xr = (const float4*)(C.x + (size_t)m * DM) + lane_; float4 v[4]; float s = 0.f;
#pragma unroll
        for (int j = 0; j < 4; ++j) { v[j] = xr[64 * j]; s += (v[j].x * v[j].x + v[j].y * v[j].y) + (v[j].z * v[j].z + v[j].w * v[j].w); }
        const float rstd = 1.0f / sqrtf(wave_sum(s) * (1.f / DM) + EPS);
        unsigned long long* o8 = (unsigned long long*)(H + (size_t)m * DM) + lane_;
#pragma unroll
        for (int j = 0; j < 4; ++j) { const float4 g = *((const float4*)C.mix_norm + lane_ + 64 * j);
            o8[64 * j] = (unsigned long long)pk2(v[j].x * rstd * g.x, v[j].y * rstd * g.y) | ((unsigned long long)pk2(v[j].z * rstd * g.z, v[j].w * rstd * g.w) << 32); }
    }
    if (C.vcu == 0) { float* tc = WSP(float, WS_ROPE); float* ts = tc + 2048;
        for (int i = tid_; i < 2048; i += NWAVES * 64) { const int pos = i >> 5, f = i & 31; const float fr = powf(10000.0f, -(float)(2 * f) / 64.0f); const float ang = (float)pos * fr; tc[i] = cosf(ang); ts[i] = sinf(ang); } }
}
__device__ __forceinline__ void phase_knorm(const Ctx& C) {
    PHASE_IDS;
    const int gw = C.vcu * NWAVES + wave_, NGW = C.G * NWAVES; const float* tc = WSP(float, WS_ROPE); const float* ts = tc + 2048; bfu* AKV = WSP(bfu, WS_AKV);
    const int l31 = lane_ & 31;
    const float4 g = *((const float4*)C.k_norm + l31);
    for (int row = gw; row < TOK; row += NGW) {
        v2u* p = (v2u*)(AKV + (size_t)row * 512 + (lane_ >> 5) * 128) + l31; const v2u w = *p;
        float xv[4] = {bflo(w.x), bfhi(w.x), bflo(w.y), bfhi(w.y)};
        float ss = (xv[0] * xv[0] + xv[1] * xv[1]) + (xv[2] * xv[2] + xv[3] * xv[3]);
#pragma unroll
        for (int o = 1; o < 32; o <<= 1) ss += __shfl_xor(ss, o);
        const float rstd = 1.0f / sqrtf(ss * (1.f / 128.f) + EPS);
        xv[0] *= rstd * g.x; xv[1] *= rstd * g.y; xv[2] *= rstd * g.z; xv[3] *= rstd * g.w;
        const int t = row & (SEQ - 1); const int dim0 = 4 * l31; const int pos = (dim0 >> 6) ? (t & 63) : (t >> 6); const int i0 = pos * 32 + (dim0 & 31);
        float ov[4];
#pragma unroll
        for (int j = 0; j < 4; ++j) { const float pr = __shfl_xor(xv[j], 8); const float c = tc[i0 + j], s = ts[i0 + j]; ov[j] = (l31 & 8) ? (xv[j] * c + pr * s) : (xv[j] * c - pr * s); }
        v2u o; o.x = pk2(ov[0], ov[1]); o.y = pk2(ov[2], ov[3]); *p = o;
    }
}
__device__ __forceinline__ gla::Io gla_io(const Ctx& C, int item, int dir) {
    gla::Io io; io.GR = WSP(float, WS_GR); io.GQK = WSP(bfu, WS_GQK); io.GV = WSP(bfu, WS_GV); io.wgk = dir ? C.wgk_b : C.wgk_f; io.bgk = dir ? C.bgk_b : C.bgk_f;
    io.ST = (float*)C.out + (size_t)(item * 2 + dir) * 32768; io.TOT = WSP(float, WS_TOT) + (item * 2 + dir) * 128;
    io.OF = WSP(bfu, WS_OF); io.UA = WSP(bfu, WS_UA); io.SG = WSP(bfu, WS_SGB); io.AQ = WSP(bfu, WS_AQ); io.gnorm = C.gla_norm; return io;
}
__device__ __forceinline__ void phase_gla_local(const Ctx& C) {
    for (int item = C.vcu; item < 256; item += C.G) { const int seg = item & 15, h = (item >> 4) & 3, b = item >> 6;
        for (int dir = 0; dir < 2; ++dir) { const gla::Io io = gla_io(C, item, dir); gla::pass<0>(C.lds, io, b, h, seg, dir, fresh_tid(C.wave_s)); } }
}
__device__ __forceinline__ void phase_gla_scan(const Ctx& C) {
    PHASE_IDS; float* ST = (float*)C.out; const float* TOT = WSP(float, WS_TOT);
    for (int idx = C.vcu * 512 + tid_; idx < 32 * 32768; idx += C.G * 512) { const int ch = idx >> 15, e = idx & 32767, dir = ch & 1, bh = ch >> 1;
        const int dk = 16 * (((e >> 8) & 15) >> 1) + 4 * ((e & 63) >> 4) + ((e >> 6) & 3);
        float loc[16], dec[16];
#pragma unroll
        for (int s = 0; s < 16; ++s) { const int seg = dir ? 15 - s : s, item = bh * 16 + seg; loc[s] = ST[(size_t)(item * 2 + dir) * 32768 + e]; dec[s] = TOT[(item * 2 + dir) * 128 + dk]; }
        float F = 0.f;
#pragma unroll
        for (int s = 0; s < 16; ++s) { const int seg = dir ? 15 - s : s, item = bh * 16 + seg; ST[(size_t)(item * 2 + dir) * 32768 + e] = F; F = __builtin_amdgcn_exp2f(1.4426950408889634f * dec[s]) * F + loc[s]; }
    }
}
__device__ __forceinline__ void phase_gla_out(const Ctx& C) {
    for (int item = C.vcu; item < 256; item += C.G) { const int seg = item & 15, h = (item >> 4) & 3, b = item >> 6;
        { const gla::Io io = gla_io(C, item, 0); gla::pass<1>(C.lds, io, b, h, seg, 0, fresh_tid(C.wave_s)); }
        __threadfence(); __syncthreads();
        { const gla::Io io = gla_io(C, item, 1); gla::pass<2>(C.lds, io, b, h, seg, 1, fresh_tid(C.wave_s)); } }
}
__device__ __forceinline__ void phase_final(const Ctx& C) {
    PHASE_IDS;
    const int gw = C.vcu * NWAVES + wave_, NGW = C.G * NWAVES; const float* rsq = WSP(float, WS_CTL) + CW_RSQ2;
    for (int m = gw; m < TOK; m += NGW) { const float rstd = 1.0f / sqrtf(rsq[m] * (1.f / DM) + EPS); float4* xr = (float4*)(C.out + (size_t)m * DM) + lane_;
#pragma unroll
        for (int j = 0; j < 4; ++j) { float4 v = xr[64 * j]; const float4 g = *((const float4*)C.final_norm + lane_ + 64 * j); v.x *= rstd * g.x; v.y *= rstd * g.y; v.z *= rstd * g.z; v.w *= rstd * g.w; xr[64 * j] = v; } }
}
__device__ __forceinline__ void phase_attn(const Ctx& C) {
    const float* tc = WSP(float, WS_ROPE); const float* ts = tc + 2048; bfu* AQ = WSP(bfu, WS_AQ); const bfu* AKV = WSP(bfu, WS_AKV);
    for (int i = 0;; ++i) {
        int grp, uig;
        if (C.G == 256) { if (i >= 2) break; grp = C.vcu >> 5; uig = (C.vcu & 31) + 32 * i; }
        else { const int u = C.vcu + i * C.G; if (u >= 512) break; grp = u >> 6; uig = u & 63; }
        const int b = grp >> 1, kvh = grp & 1, hq = kvh * 4 + (uig >> 4), qb = uig & 15;
        const size_t r0 = (size_t)b * SEQ + qb * 256;
        attn::attn_unit(AQ + r0 * 1024 + hq * 128, AKV + (size_t)b * SEQ * 512 + kvh * 128, AKV + (size_t)b * SEQ * 512 + 256 + kvh * 128, ((DIAG == 4 || DIAG == 5) ? WSP(bfu, WS_OF) : AQ) + r0 * 1024 + hq * 128,
                        qb * 256, C.q_norm, tc, ts, SEQ, C.ldsg, fresh_tid(C.wave_s));
    }
}

constexpr int N_PHASES = 9;
struct Args { const float* in[16]; float* out; unsigned char* ws; int ph_lo, ph_hi; };
__global__ void __launch_bounds__(NWAVES * 64, 2) mk_fwd(Args args) {
    extern __shared__ __attribute__((aligned(16))) unsigned char lds[];
    Ctx C;
    C.lds = (LAS unsigned char*)lds; C.ldsg = (char*)lds;
    C.wave_s = __builtin_amdgcn_readfirstlane(threadIdx.x >> 6);
    C.G = gridDim.x; { const int bx = blockIdx.x; C.vcu = (C.G % 8 == 0) ? (bx % 8) * (C.G / 8) + bx / 8 : bx; }
    C.x = args.in[0]; C.mix_norm = args.in[1]; C.w_in = args.in[2]; C.wgk_f = args.in[3]; C.bgk_f = args.in[4]; C.wgk_b = args.in[5]; C.bgk_b = args.in[6]; C.gla_norm = args.in[7];
    C.q_norm = args.in[8]; C.k_norm = args.in[9]; C.b_gate = args.in[10]; C.w_o = args.in[11]; C.ffn_norm = args.in[12]; C.w_gu = args.in[13]; C.w_dn = args.in[14]; C.final_norm = args.in[15];
    C.out = args.out; C.ws = args.ws;
    volatile LAS unsigned* MISC = (volatile LAS unsigned*)(C.lds + MISC_OFF);
    for (int u = threadIdx.x; u < (LDS_BYTES - RING_BYTES) / 4; u += NWAVES * 64) ((LAS unsigned*)(C.lds + RING_BYTES))[u] = 0u;
    __syncthreads();
    unsigned* ctl = (unsigned*)(C.ws + WS_CTL);
    XcdBarrier bar; bar.bar = ctl + CW_BAR; bar.x = 0; bar.st = nullptr;
    if (MK_N_LAUNCHES == 1) bar = xcd_barrier_post(ctl + CW_BAR, MISC + 8);
#define GRID_BAR() do { if (MK_N_LAUNCHES == 1) xcd_barrier(bar); } while (0)
    const int lo = args.ph_lo, hi = args.ph_hi;
#ifdef ONLY_PHASE
#define IN(k) ((k) == ONLY_PHASE && lo <= (k) && (k) < hi)
#else
#define IN(k) (lo <= (k) && (k) < hi)
#endif
#define BOTH(k) (IN(k) && IN((k) + 1))
    float* RSQ1 = (float*)ctl + CW_RSQ1; float* RSQ2 = (float*)ctl + CW_RSQ2;

    if (IN(0)) {
        phase_prologue(C); if (BOTH(0)) GRID_BAR(); }
    if (IN(1)) {
        pg8::Gemm g{(const pg8::bf16_t*)C.out, WSP(pg8::bf16_t, WS_WIN), TOK, NIN, DM}; pg8::StaticOrder S; S.init(TOK, NIN, C.G, (int)blockIdx.x);
        pg8::EpiIn E{WSP(pg8::bf16_t, WS_GQK), WSP(pg8::bf16_t, WS_GV), WSP(pg8::bf16_t, WS_UA), WSP(pg8::bf16_t, WS_SGB), WSP(pg8::bf16_t, WS_AQ), WSP(pg8::bf16_t, WS_AKV), WSP(float, WS_GR), C.b_gate};
        pg8::gemm_phase<pg8::EpiIn, pg8::StaticOrder, true, true>(C.lds, g, S, E, fresh_tid(C.wave_s));
        if (BOTH(1)) GRID_BAR();
    }
    if (IN(2)) { phase_knorm(C); phase_gla_local(C); if (BOTH(2)) GRID_BAR(); }
    if (IN(3)) { phase_gla_scan(C); phase_attn(C); if (BOTH(3)) GRID_BAR(); }
    if (IN(4)) { phase_gla_out(C); if (BOTH(4)) GRID_BAR(); }
    if (IN(5)) {
        pg8::Gemm g{WSP(pg8::bf16_t, WS_AQ), WSP(pg8::bf16_t, WS_WO), TOK, DM, DM}; pg8::StaticOrder S; S.init(TOK, DM, C.G, (int)blockIdx.x);
        pg8::EpiRes E{C.x, C.out, WSP(pg8::bf16_t, WS_GQK), RSQ1};
        pg8::gemm_phase<pg8::EpiRes, pg8::StaticOrder, true, true>(C.lds, g, S, E, fresh_tid(C.wave_s));
        if (BOTH(5)) GRID_BAR();
    }
    if (IN(6)) {
        pg8::Gemm g{WSP(pg8::bf16_t, WS_GQK), WSP(pg8::bf16_t, WS_WGU), TOK, 2 * DFF, DM}; pg8::StaticOrder S; S.init(TOK, 2 * DFF, C.G, (int)blockIdx.x);
        pg8::EpiGU E{WSP(pg8::bf16_t, WS_ACT), RSQ1};
        pg8::gemm_phase<pg8::EpiGU, pg8::StaticOrder, true, true>(C.lds, g, S, E, fresh_tid(C.wave_s));
        if (BOTH(6)) GRID_BAR();
    }
    if (IN(7)) {
        pg8::Gemm g{WSP(pg8::bf16_t, WS_ACT), WSP(pg8::bf16_t, WS_WDN), TOK, DM, DFF}; pg8::StaticOrder S; S.init(TOK, DM, C.G, (int)blockIdx.x);
        pg8::EpiRes E{C.out, C.out, nullptr, RSQ2};
        pg8::gemm_phase<pg8::EpiRes, pg8::StaticOrder, true, true>(C.lds, g, S, E, fresh_tid(C.wave_s));
        if (BOTH(7)) GRID_BAR();
    }
    if (IN(8)) { phase_final(C); }
#undef IN
#undef BOTH
}

extern "C" void kernel_launch(void* const* d_in, const int* in_sizes, int n_in, void* d_out, int out_size, void* d_ws, size_t ws_size, hipStream_t stream) {
    static int grid = 0;
    if (grid == 0) {
        if (n_in != 16 || in_sizes[0] != TOK * DM || out_size != TOK * DM || ws_size < WS_END) { fprintf(stderr, "kernel_launch: unexpected shapes (n_in %d, in0 %d, out %d, ws %zu)\n", n_in, n_in > 0 ? in_sizes[0] : -1, out_size, ws_size); grid = -1; return; }
        int dev = 0, cus = 0, per_cu = 0;
        if (hipGetDevice(&dev) != hipSuccess || hipDeviceGetAttribute(&cus, hipDeviceAttributeMultiprocessorCount, dev) != hipSuccess) { grid = -1; return; }
        if (hipFuncSetAttribute((const void*)mk_fwd, hipFuncAttributeMaxDynamicSharedMemorySize, LDS_BYTES) != hipSuccess) { fprintf(stderr, "kernel_launch: hipFuncSetAttribute failed\n"); grid = -1; return; }
        if (hipOccupancyMaxActiveBlocksPerMultiprocessor(&per_cu, (const void*)mk_fwd, NWAVES * 64, LDS_BYTES) != hipSuccess || per_cu < 1) { fprintf(stderr, "kernel_launch: occupancy query says %d blocks per CU\n", per_cu); }
        (void)hipGetLastError();
        grid = cus;
    }
    if (grid < 0) return;
    (void)hipMemsetAsync((char*)d_ws + WS_CTL, 0, CTL_ZERO_BYTES, stream);
    Args a{};
    for (int i = 0; i < 16; ++i) a.in[i] = (const float*)d_in[i];
    a.out = (float*)d_out; a.ws = (unsigned char*)d_ws;
    if (MK_N_LAUNCHES == 1) { a.ph_lo = 0; a.ph_hi = N_PHASES; hipLaunchKernelGGL(mk_fwd, dim3(grid), dim3(NWAVES * 64), LDS_BYTES, stream, a); }
    else for (int p = 0; p < N_PHASES; ++p) { a.ph_lo = p; a.ph_hi = p + 1; hipLaunchKernelGGL(mk_fwd, dim3(grid), dim3(NWAVES * 64), LDS_BYTES, stream, a); }
    const hipError_t le = hipPeekAtLastError();
    if (le != hipSuccess) fprintf(stderr, "kernel_launch: launch failed: %s\n", hipGetErrorName(le));
}
```

```cpp
#include <hip/hip_runtime.h>
#include <hip/hip_bf16.h>
#include <cstdio>
#include <cstdint>
#include <cmath>

#ifndef DIAG
#define DIAG 0
#endif


#ifndef MK_N_LAUNCHES
#define MK_N_LAUNCHES 1
#endif

constexpr int BATCH = 4, SEQ = 4096, DM = 1024, TOK = BATCH * SEQ;
constexpr int GH = 4, GDK = 128, GDV = 256, GRANK = 16;
constexpr int AH = 8, AKVH = 2, AHD = 128;
constexpr int DFF = 2816, DIN = 6688, NIN = 6912;
constexpr float EPS = 1e-6f;
constexpr int NWAVES = 8;

constexpr size_t MiB = 1u << 20;
constexpr size_t WS_CTL = 0, CTL_ZERO_BYTES = 1 * MiB;
constexpr size_t WS_WIN = 1 * MiB;
constexpr size_t WS_WO = 15 * MiB;
constexpr size_t WS_WGU = 17 * MiB;
constexpr size_t WS_WDN = 28 * MiB;
constexpr size_t WS_ROPE = 34 * MiB;
constexpr size_t WS_GR = 35 * MiB;
constexpr size_t WS_TOT = 38 * MiB;
constexpr size_t WS_GQK = 40 * MiB;
constexpr size_t WS_GV = 72 * MiB;
constexpr size_t WS_UA = 104 * MiB;
constexpr size_t WS_SGB = 136 * MiB;
constexpr size_t WS_AQ = 168 * MiB;
constexpr size_t WS_AKV = 200 * MiB;
constexpr size_t WS_OF = 216 * MiB;
constexpr size_t WS_ACT = WS_GV;
constexpr size_t WS_END = 256 * MiB;
static_assert(WS_ACT + (size_t)TOK * DFF * 2 <= WS_AQ, "act overlay");
constexpr int CW_BAR = 4096;
constexpr int CW_RSQ1 = 32768;
constexpr int CW_RSQ2 = 65536;
static_assert((CW_RSQ2 + TOK) * 4 <= (int)CTL_ZERO_BYTES, "ctl");

constexpr int RING_BYTES = 131072;
constexpr int LDS_BYTES = 163840;
constexpr int MISC_OFF = LDS_BYTES - 512 + 320;

#define GAS __attribute__((address_space(1)))
#define LAS __attribute__((address_space(3)))
typedef unsigned short bfu;
typedef unsigned v4u __attribute__((ext_vector_type(4)));
typedef unsigned v2u __attribute__((ext_vector_type(2)));
typedef GAS unsigned gu32;
#define RLX_AGENT __ATOMIC_RELAXED, __HIP_MEMORY_SCOPE_AGENT
#define LDS_WAIT() asm volatile("s_waitcnt lgkmcnt(0)" ::: "memory")
#define VM_WAIT() asm volatile("s_waitcnt vmcnt(0)" ::: "memory")
__device__ __forceinline__ unsigned f2bf(float f) { unsigned u = __builtin_bit_cast(unsigned, f); return (u + 0x7fffu + ((u >> 16) & 1u)) >> 16; }
__device__ __forceinline__ unsigned pk2(float lo, float hi) { return f2bf(lo) | (f2bf(hi) << 16); }
__device__ __forceinline__ float bf2f(unsigned short b) { return __builtin_bit_cast(float, (unsigned)b << 16); }
__device__ __forceinline__ float bflo(unsigned w) { return __builtin_bit_cast(float, w << 16); }
__device__ __forceinline__ float bfhi(unsigned w) { return __builtin_bit_cast(float, w & 0xffff0000u); }
__device__ __forceinline__ float sigmoidf_(float x) { return __builtin_amdgcn_rcpf(1.0f + __builtin_amdgcn_exp2f(-1.4426950408889634f * x)); }
__device__ __forceinline__ float wave_sum_dpp(float x) {
#define DPPF(v, ctrl, rmask) __builtin_bit_cast(float, __builtin_amdgcn_update_dpp(0, __builtin_bit_cast(int, (v)), (ctrl), (rmask), 0xF, false))
    x += DPPF(x, 0xB1, 0xF); x += DPPF(x, 0x4E, 0xF); x += DPPF(x, 0x141, 0xF); x += DPPF(x, 0x140, 0xF);
    x += DPPF(x, 0x142, 0xA); x += DPPF(x, 0x143, 0xC);
#undef DPPF
    return __builtin_bit_cast(float, __builtin_amdgcn_readlane(__builtin_bit_cast(int, x), 63));
}
__device__ __forceinline__ float wave_sum(float v) {
#pragma unroll
    for (int o = 1; o < 64; o <<= 1) v += __shfl_xor(v, o);
    return v;
}

namespace pg8 {
#define PG8_LAS __attribute__((address_space(3)))
typedef unsigned short bf16_t;
typedef short bf16x8 __attribute__((ext_vector_type(8)));
typedef float f32x4 __attribute__((ext_vector_type(4)));
typedef unsigned u32x4 __attribute__((ext_vector_type(4)));
constexpr int BM = 256, BK = 64, HALF = 128, HTB = HALF * BK * 2  , STAGE_BYTES = 8 * HTB, NXCD = 8, WGM = 8;

__host__ __device__ __forceinline__ int lds_byte(int r, int c) { const int st = (r >> 4) * 2 + (c >> 5), rr = r & 15, cc = c & 31, ob = rr * 64 + cc * 2; return st * 1024 + (ob ^ (((ob >> 9) & 1) << 5)); }
__host__ __device__ __forceinline__ void stage_rc(int b, int& R, int& C) { const int st = b / 1024, sb = b % 1024, swz = sb ^ (((sb >> 9) & 1) << 5); R = (st >> 1) * 16 + swz / 64; C = (st & 1) * 32 + (swz % 64) / 2; }
__host__ __device__ __forceinline__ int perm32(int rho) { const int n = rho >> 4, i = rho & 15; return 8 * (i >> 2) + 4 * n + (i & 3); }

struct Unit { int pm, pn; };
struct Gemm { const bf16_t* A; const bf16_t* Bt; int M, N, K; };

struct StaticOrder {
    int nM, nN, nwg, G, c;
    __host__ __device__ void init(int M, int N, int G_, int c_) { nM = M / BM; nN = N / BM; nwg = nM * nN; G = G_; c = c_; }
    __host__ __device__ bool next(int i, Unit& u) const {
        const long L = (long)i * G + c; if (L >= nwg) return false;
        int wgid = (int)L; { const int q = nwg / NXCD, r = nwg % NXCD, xcd = wgid % NXCD, off = wgid / NXCD; wgid = (xcd < r ? xcd * (q + 1) : r * (q + 1) + (xcd - r) * q) + off; }
        const int nig = WGM * nN, gid = wgid / nig, fm = gid * WGM, gsz = (nM - fm) < WGM ? (nM - fm) : WGM;
        u.pm = fm + ((wgid % nig) % gsz); u.pn = (wgid % nig) / gsz; return true;
    }
    __device__ __forceinline__ void a_ready(const Unit&) const {}
    __device__ __forceinline__ void done(const Unit&) const {}
};

typedef float f32x2 __attribute__((ext_vector_type(2)));
typedef __bf16 bf16x2v __attribute__((ext_vector_type(2)));
__device__ __forceinline__ unsigned cvt_pk_bf16(float lo, float hi) { const f32x2 v = {lo, hi}; return __builtin_bit_cast(unsigned, __builtin_convertvector(v, bf16x2v)); }

__device__ __forceinline__ float sigm(float x) { return __builtin_amdgcn_rcpf(1.0f + __builtin_amdgcn_exp2f(-1.4426950408889634f * x)); }
__device__ __forceinline__ u32x4 pack8(f32x4 a, f32x4 b) { u32x4 w; w.x = cvt_pk_bf16(a[0], a[1]); w.y = cvt_pk_bf16(a[2], a[3]); w.z = cvt_pk_bf16(b[0], b[1]); w.w = cvt_pk_bf16(b[2], b[3]); return w; }

struct EpiIn {
    static constexpr bool PERM = true, AFTER_DRAIN = false;
    bf16_t *GQK, *GV, *UA, *SGB, *AQ, *AKV; float* GR; const float* bgate;
    __device__ __forceinline__ void operator()(const f32x4 (&acc)[2][2][4][2], const Unit& u, int wr, int wc, int fr, int fq) const {
        const int pn = u.pn, row0 = u.pm * BM + wr * 64 + fr, cl = wc * 32 + 8 * fq;
        if (pn < 8 || (pn >= 16 && pn < 22)) {
            bf16_t* base; int ld, colt; float sc = 1.f;
            if (pn < 2) { base = GQK; ld = 1024; colt = pn * 256; sc = 0.08838834764831845f; }
            else if (pn < 4) { base = GQK; ld = 1024; colt = 512 + (pn - 2) * 256; }
            else if (pn < 8) { base = GV; ld = 1024; colt = (pn - 4) * 256; }
            else if (pn < 20) { base = AQ; ld = 1024; colt = (pn - 16) * 256; }
            else { base = AKV; ld = 512; colt = (pn - 20) * 256; }
#pragma unroll
            for (int ai = 0; ai < 2; ++ai)
#pragma unroll
                for (int m = 0; m < 4; ++m) { bf16_t* rowp = base + (size_t)(row0 + ai * HALF + m * 16) * ld + colt + cl;
#pragma unroll
                    for (int bj = 0; bj < 2; ++bj) *(u32x4*)(rowp + bj * HALF) = pack8(acc[ai][bj][m][0] * sc, acc[ai][bj][m][1] * sc); }
        } else if (pn < 16) {
            const int ub = (pn - 8) * 128 + cl;
            const f32x4 b0 = *(const f32x4*)(bgate + ub), b1 = *(const f32x4*)(bgate + ub + 4);
#pragma unroll
            for (int ai = 0; ai < 2; ++ai)
#pragma unroll
                for (int m = 0; m < 4; ++m) { f32x4 o[2];
#pragma unroll
                    for (int n = 0; n < 2; ++n) { const f32x4 g = acc[ai][0][m][n], a = acc[ai][1][m][n] + (n ? b1 : b0);
#pragma unroll
                        for (int j = 0; j < 4; ++j) o[n][j] = g[j] * sigm(g[j]) * sigm(a[j]); }
                    *(u32x4*)(UA + (size_t)(row0 + ai * HALF + m * 16) * 1024 + ub) = pack8(o[0], o[1]); }
        } else if (pn < 26) {
#pragma unroll
            for (int bj = 0; bj < 2; ++bj) { const int col = (pn - 22) * 256 + bj * HALF + cl;
                const f32x4 b0 = *(const f32x4*)(bgate + 1024 + col), b1 = *(const f32x4*)(bgate + 1024 + col + 4);
#pragma unroll
                for (int ai = 0; ai < 2; ++ai)
#pragma unroll
                    for (int m = 0; m < 4; ++m) { f32x4 o[2];
#pragma unroll
                        for (int n = 0; n < 2; ++n) { const f32x4 a = acc[ai][bj][m][n] + (n ? b1 : b0);
#pragma unroll
                            for (int j = 0; j < 4; ++j) o[n][j] = sigm(a[j]); }
                        *(u32x4*)(SGB + (size_t)(row0 + ai * HALF + m * 16) * 1024 + col) = pack8(o[0], o[1]); } }
        } else {
            if (wc == 0) {
#pragma unroll
                for (int ai = 0; ai < 2; ++ai)
#pragma unroll
                    for (int m = 0; m < 4; ++m) { float* rp = GR + (size_t)(row0 + ai * HALF + m * 16) * 32 + 8 * fq;
                        *(f32x4*)rp = acc[ai][0][m][0]; *(f32x4*)(rp + 4) = acc[ai][0][m][1]; }
            }
        }
    }
};
struct EpiRes {
    static constexpr bool PERM = false, AFTER_DRAIN = false;
    const float* xi; float* xo; bf16_t* xb; float* rsq;
    __device__ __forceinline__ void operator()(const f32x4 (&acc)[2][2][4][2], const Unit& u, int wr, int wc, int fr, int fq) const {
        const int row0 = u.pm * BM + wr * 64 + fr, col0 = u.pn * BM + wc * 32 + 4 * fq;
#pragma unroll
        for (int ai = 0; ai < 2; ++ai)
#pragma unroll
            for (int m = 0; m < 4; ++m) { const int row = row0 + ai * HALF + m * 16; const size_t off = (size_t)row * 1024 + col0; float ss = 0.f;
#pragma unroll
                for (int bj = 0; bj < 2; ++bj)
#pragma unroll
                    for (int n = 0; n < 2; ++n) { const size_t o2 = off + bj * HALF + n * 16; const f32x4 o = *(const f32x4*)(xi + o2) + acc[ai][bj][m][n];
                        *(f32x4*)(xo + o2) = o; ss += (o[0] * o[0] + o[1] * o[1]) + (o[2] * o[2] + o[3] * o[3]);
                        if (xb) { typedef unsigned u32x2v __attribute__((ext_vector_type(2))); u32x2v w; w.x = cvt_pk_bf16(o[0], o[1]); w.y = cvt_pk_bf16(o[2], o[3]); *(u32x2v*)(xb + o2) = w; } }
                ss += __shfl_xor(ss, 16); ss += __shfl_xor(ss, 32);
                if (fq == 0) atomicAdd(rsq + row, ss); }
    }
};
struct EpiGU {
    static constexpr bool PERM = true, AFTER_DRAIN = false;
    bf16_t* ACT; const float* rsq;
    __device__ __forceinline__ void operator()(const f32x4 (&acc)[2][2][4][2], const Unit& u, int wr, int wc, int fr, int fq) const {
        const int row0 = u.pm * BM + wr * 64 + fr, col = u.pn * 128 + wc * 32 + 8 * fq;
#pragma unroll
        for (int ai = 0; ai < 2; ++ai)
#pragma unroll
            for (int m = 0; m < 4; ++m) { const int row = row0 + ai * HALF + m * 16; const float rstd = 1.0f / sqrtf(rsq[row] * (1.0f / 1024.0f) + 1e-6f); f32x4 o[2];
#pragma unroll
                for (int n = 0; n < 2; ++n) { const f32x4 g = acc[ai][0][m][n] * rstd, v = acc[ai][1][m][n] * rstd;
#pragma unroll
                    for (int j = 0; j < 4; ++j) o[n][j] = g[j] * sigm(g[j]) * v[j]; }
                *(u32x4*)(ACT + (size_t)row * 2816 + col) = pack8(o[0], o[1]); }
    }
};
template <class Epi, class Sched, bool ALIGN_EPI = false, bool SP2 = false>
__device__ __forceinline__ void gemm_phase(PG8_LAS unsigned char* lds, const Gemm g, const Sched& S, const Epi& E, const int tid) {
    const int wid = __builtin_amdgcn_readfirstlane(tid >> 6), lane = tid & 63, wr = wid >> 2, wc = wid & 3, fr = lane & 15, fq = lane >> 4;
    const int K = g.K, nt = K / BK;
    unsigned voffA[2], voffB[2];
#pragma unroll
    for (int i = 0; i < 2; ++i) { int R, C; stage_rc(tid * 16 + i * 8192, R, C); const int Rb = Epi::PERM ? ((R & ~31) + perm32(R & 31)) : R;
        voffA[i] = (unsigned)(R * K + C) * 2u; voffB[i] = (unsigned)(Rb * K + C) * 2u; }
    const size_t kstep = (size_t)(BK * 2);
    const size_t hstep = (size_t)HALF * K * 2;
    const size_t tstep = 2 * hstep;
    const unsigned ldsw = (unsigned)wid * 1024u;
    const int aoff = lds_byte(wr * 64 + fr, fq * 8), boff = lds_byte(wc * 32 + fr, fq * 8);
#define PG8_SA(b, h) (((b) * 2 + (h)) * HTB)
#define PG8_SB(b, h) ((4 + (b) * 2 + (h)) * HTB)
#define PG8_STAGE(bufoff, gbase, voff) do { _Pragma("unroll") for (int _i = 0; _i < 2; ++_i) \
        __builtin_amdgcn_global_load_lds((const unsigned*)((const char*)(gbase) + (voff)[_i]), (PG8_LAS unsigned*)(lds + (bufoff) + ldsw + _i * 8192), 16, 0, 0); } while (0)
#define PG8_LDA(dst, b, h) do { _Pragma("unroll") for (int m = 0; m < 4; ++m) _Pragma("unroll") for (int k = 0; k < 2; ++k) dst[m][k] = *(const PG8_LAS bf16x8*)(lds + PG8_SA(b, h) + aoff + m * 2048 + k * 1024); } while (0)
#define PG8_LDB(dst, b, h) do { _Pragma("unroll") for (int n = 0; n < 2; ++n) _Pragma("unroll") for (int k = 0; k < 2; ++k) dst[n][k] = *(const PG8_LAS bf16x8*)(lds + PG8_SB(b, h) + boff + n * 2048 + k * 1024); } while (0)
#define PG8_MMA(ai, bj, At, Bt) do { __builtin_amdgcn_s_setprio(1); _Pragma("unroll") for (int m = 0; m < 4; ++m) _Pragma("unroll") for (int n = 0; n < 2; ++n) _Pragma("unroll") for (int k = 0; k < 2; ++k) \
        acc[ai][bj][m][n] = __builtin_amdgcn_mfma_f32_16x16x32_bf16(Bt[n][k], At[m][k], acc[ai][bj][m][n], 0, 0, 0); __builtin_amdgcn_s_setprio(0); } while (0)
#define PG8_WAIT_V(n) asm volatile("s_waitcnt vmcnt(" #n ")" ::: "memory")
#define PG8_WAIT_L(n) asm volatile("s_waitcnt lgkmcnt(" #n ")" ::: "memory")
#define PG8_BAR __builtin_amdgcn_s_barrier()
#define PG8_SCHED __builtin_amdgcn_sched_barrier(0)
    Unit cur, nxt; int ui = 0;
    if (!S.next(0, cur)) return;
    f32x4 acc[2][2][4][2];
#pragma unroll
    for (int a = 0; a < 2; ++a)
#pragma unroll
        for (int b = 0; b < 2; ++b)
#pragma unroll
            for (int m = 0; m < 4; ++m)
#pragma unroll
                for (int n = 0; n < 2; ++n) acc[a][b][m][n] = (f32x4){0.f, 0.f, 0.f, 0.f};
    bf16x8 At[4][2], B0[2][2], B1[2][2];
    const char* cA = (const char*)g.A + (size_t)cur.pm * tstep; const char* cB = (const char*)g.Bt + (size_t)cur.pn * tstep;
    S.a_ready(cur);
    if constexpr (SP2) {
        PG8_STAGE(PG8_SB(0, 0), cB, voffB); PG8_STAGE(PG8_SB(0, 1), cB + hstep, voffB); PG8_STAGE(PG8_SA(0, 0), cA, voffA); PG8_STAGE(PG8_SA(0, 1), cA + hstep, voffA);
        if (wr == 1) PG8_BAR;
        PG8_WAIT_V(2); PG8_BAR;
        PG8_STAGE(PG8_SB(1, 0), cB + kstep, voffB); PG8_STAGE(PG8_SA(1, 0), cA + kstep, voffA); PG8_STAGE(PG8_SB(1, 1), cB + hstep + kstep, voffB);
        PG8_WAIT_V(6); PG8_BAR;
    } else {
        PG8_STAGE(PG8_SB(0, 0), cB, voffB); PG8_STAGE(PG8_SA(0, 0), cA, voffA); PG8_STAGE(PG8_SB(0, 1), cB + hstep, voffB); PG8_STAGE(PG8_SA(0, 1), cA + hstep, voffA);
        if (wr == 1) PG8_BAR;
        PG8_WAIT_V(4); PG8_BAR;
        PG8_STAGE(PG8_SB(1, 0), cB + kstep, voffB); PG8_STAGE(PG8_SA(1, 0), cA + kstep, voffA); PG8_STAGE(PG8_SB(1, 1), cB + hstep + kstep, voffB);
        PG8_WAIT_V(6); PG8_BAR;
    }
    for (;;) {
        const bool has_next = S.next(ui + 1, nxt);
        const char* nA = has_next ? (const char*)g.A + (size_t)nxt.pm * tstep : cA; const char* nB = has_next ? (const char*)g.Bt + (size_t)nxt.pn * tstep : cB;
        for (int t = 0; t < nt; t += 2) {
            const bool last = (t == nt - 2);
            const char* a1 = cA + (size_t)(t + 1) * kstep;
            const char* a2 = last ? nA : cA + (size_t)(t + 2) * kstep; const char* b2 = last ? nB : cB + (size_t)(t + 2) * kstep;
            const char* a3 = a2 + kstep; const char* b3 = b2 + kstep;
            if (last && has_next) S.a_ready(nxt);
            if constexpr (SP2) {
            PG8_LDB(B0, 0, 0); PG8_LDB(B1, 0, 1); PG8_SCHED; PG8_LDA(At, 0, 0); PG8_STAGE(PG8_SA(1, 1), a1 + hstep, voffA);
            PG8_WAIT_V(8); PG8_WAIT_L(0); PG8_BAR; PG8_MMA(0, 0, At, B0); PG8_MMA(0, 1, At, B1); PG8_BAR; PG8_SCHED;
            PG8_LDA(At, 0, 1); PG8_STAGE(PG8_SB(0, 0), b2, voffB); PG8_STAGE(PG8_SB(0, 1), b2 + hstep, voffB); PG8_STAGE(PG8_SA(0, 0), a2, voffA);
            PG8_WAIT_V(8); PG8_WAIT_L(0); PG8_BAR; PG8_MMA(1, 0, At, B0); PG8_MMA(1, 1, At, B1); PG8_BAR; PG8_SCHED;
            PG8_LDB(B0, 1, 0); PG8_LDB(B1, 1, 1); PG8_SCHED; PG8_LDA(At, 1, 0); PG8_STAGE(PG8_SA(0, 1), a2 + hstep, voffA);
            PG8_WAIT_V(8); PG8_WAIT_L(0); PG8_BAR; PG8_MMA(0, 0, At, B0); PG8_MMA(0, 1, At, B1); PG8_BAR; PG8_SCHED;
            PG8_LDA(At, 1, 1); PG8_STAGE(PG8_SB(1, 0), b3, voffB); PG8_STAGE(PG8_SB(1, 1), b3 + hstep, voffB); PG8_STAGE(PG8_SA(1, 0), a3, voffA);
            PG8_WAIT_V(8); PG8_WAIT_L(0); PG8_BAR; PG8_MMA(1, 0, At, B0); PG8_MMA(1, 1, At, B1); PG8_BAR; PG8_SCHED;
            } else {
            PG8_LDB(B0, 0, 0); PG8_SCHED; PG8_LDA(At, 0, 0); PG8_STAGE(PG8_SA(1, 1), a1 + hstep, voffA);
            PG8_WAIT_L(8); PG8_BAR; PG8_WAIT_L(0); PG8_MMA(0, 0, At, B0); PG8_BAR; PG8_SCHED;
            PG8_LDB(B1, 0, 1); PG8_STAGE(PG8_SB(0, 0), b2, voffB);
            PG8_BAR; PG8_WAIT_L(0); PG8_MMA(0, 1, At, B1); PG8_BAR;
            PG8_LDA(At, 0, 1); PG8_STAGE(PG8_SA(0, 0), a2, voffA);
            PG8_BAR; PG8_WAIT_L(0); PG8_MMA(1, 0, At, B0); PG8_BAR; PG8_SCHED;
            PG8_STAGE(PG8_SB(0, 1), b2 + hstep, voffB);
            PG8_WAIT_V(6); PG8_BAR; PG8_MMA(1, 1, At, B1); PG8_BAR;
            PG8_LDB(B0, 1, 0); PG8_SCHED; PG8_LDA(At, 1, 0); PG8_STAGE(PG8_SA(0, 1), a2 + hstep, voffA);
            PG8_WAIT_L(8); PG8_BAR; PG8_WAIT_L(0); PG8_MMA(0, 0, At, B0); PG8_BAR; PG8_SCHED;
            PG8_LDB(B1, 1, 1); PG8_STAGE(PG8_SB(1, 0), b3, voffB);
            PG8_BAR; PG8_WAIT_L(0); PG8_MMA(0, 1, At, B1); PG8_BAR;
            PG8_LDA(At, 1, 1); PG8_STAGE(PG8_SA(1, 0), a3, voffA);
            PG8_BAR; PG8_WAIT_L(0); PG8_MMA(1, 0, At, B0); PG8_BAR; PG8_SCHED;
            PG8_STAGE(PG8_SB(1, 1), b3 + hstep, voffB);
            PG8_WAIT_V(6); PG8_BAR; PG8_MMA(1, 1, At, B1); PG8_BAR;
            }
        }
        if constexpr (ALIGN_EPI) { if (wr == 0) PG8_BAR; }
        if constexpr (!Epi::AFTER_DRAIN) { E(acc, cur, wr, wc, fr, fq); S.done(cur); }
        if (!has_next) break;
#pragma unroll
        for (int a = 0; a < 2; ++a)
#pragma unroll
            for (int b = 0; b < 2; ++b)
#pragma unroll
                for (int m = 0; m < 4; ++m)
#pragma unroll
                    for (int n = 0; n < 2; ++n) acc[a][b][m][n] = (f32x4){0.f, 0.f, 0.f, 0.f};
        cur = nxt; cA = nA; cB = nB; ++ui;
        if constexpr (ALIGN_EPI) { if (wr == 1) PG8_BAR; }
    }
    PG8_WAIT_V(0);
    if constexpr (!ALIGN_EPI) { if (wr == 0) PG8_BAR; }
    PG8_BAR;
    if constexpr (Epi::AFTER_DRAIN) { E.fused(acc, cur, wr, wc, fr, fq, lds, wid, lane); S.done(cur); }
#undef PG8_SA
#undef PG8_SB
#undef PG8_STAGE
#undef PG8_LDA
#undef PG8_LDB
#undef PG8_MMA
#undef PG8_WAIT_V
#undef PG8_WAIT_L
#undef PG8_BAR
#undef PG8_SCHED
}
}

namespace attn {
constexpr int D = 128, NW = 8, QBLK = 32, KVBLK = 64;
constexpr float SCALE = 0.088388347648318440f;
constexpr float THR = 8.f;
#ifndef ATTN_SDEPTH
#define ATTN_SDEPTH 1
#endif
constexpr int SDEPTH = ATTN_SDEPTH;
constexpr int LDQ = 1024, LDK = 512, LDO = 1024;
constexpr size_t SHM_V = KVBLK * D * 2, SHM_K = KVBLK * D * 2, SHM_ATTN = 2 * SHM_V + 2 * SHM_K + NW * 64 * 4;
using bf16 = __hip_bfloat16;
using bf16x8 = __attribute__((ext_vector_type(8))) short;
using s16x4  = __attribute__((ext_vector_type(4))) short;
using f32x16 = __attribute__((ext_vector_type(16))) float;
using f32x8  = __attribute__((ext_vector_type(8))) float;
using u32x4  = __attribute__((ext_vector_type(4))) unsigned;
#define KSWZ(row, colB) ((row) * 256 + ((colB) ^ (((row) & 7) << 4)))
#define SBAR() __builtin_amdgcn_sched_barrier(0)
__device__ __forceinline__ int crow(int r, int hi) { return (r & 3) + 8 * (r >> 2) + 4 * hi; }
typedef float f32x2a __attribute__((ext_vector_type(2))); typedef __bf16 bf16x2a __attribute__((ext_vector_type(2)));
__device__ __forceinline__ unsigned cvtpk(float lo, float hi) { const f32x2a v = {lo, hi}; return __builtin_bit_cast(unsigned, __builtin_convertvector(v, bf16x2a)); }
template <typename TIn> struct Stage;
template <> struct Stage<bf16>  { using T = bf16x8;
  __device__ static __forceinline__ T ld8(const bf16* p) { return *reinterpret_cast<const bf16x8*>(p); }
  __device__ static __forceinline__ bf16x8 tobf(T x) { return x; } };
template <> struct Stage<float> { using T = f32x8;
  __device__ static __forceinline__ T ld8(const float* p) { return *reinterpret_cast<const f32x8*>(p); }
  __device__ static __forceinline__ bf16x8 tobf(T x) {
    u32x4 w = {cvtpk(x[0], x[1]), cvtpk(x[2], x[3]), cvtpk(x[4], x[5]), cvtpk(x[6], x[7])}; return *reinterpret_cast<bf16x8*>(&w); } };

__device__ __forceinline__ void partialSM(f32x16& p0, f32x16& p1, float& m_reg, float& mn, float& alpha) {
  constexpr float C = SCALE * 1.4426950408889634f;
  float pmax = p0[0]; for (int r = 1; r < 16; ++r) pmax = fmaxf(pmax, p0[r]); for (int r = 0; r < 16; ++r) pmax = fmaxf(pmax, p1[r]);
  { auto rr = __builtin_amdgcn_permlane32_swap(__float_as_uint(pmax), __float_as_uint(pmax), false, false);
    pmax = fmaxf(__uint_as_float(rr[0]), __uint_as_float(rr[1])); }
  if (__builtin_expect(__all(pmax - m_reg <= THR / SCALE), 1)) { mn = m_reg; alpha = 1.f; }
  else { mn = fmaxf(m_reg, pmax); alpha = __builtin_amdgcn_exp2f((m_reg - mn) * C); m_reg = mn; }
  float mnC = -mn * C;
  for (int r = 0; r < 16; ++r) p0[r] = fmaf(p0[r], C, mnC); for (int r = 0; r < 16; ++r) p1[r] = fmaf(p1[r], C, mnC);
  for (int r = 0; r < 16; ++r) p0[r] = __builtin_amdgcn_exp2f(p0[r]);
}
__device__ __forceinline__ void finishSM(f32x16& p0, f32x16& p1, float alpha, float& l_reg, bf16x8& pa0, bf16x8& pa1, bf16x8& pa2, bf16x8& pa3) {
  for (int r = 0; r < 16; ++r) p1[r] = __builtin_amdgcn_exp2f(p1[r]);
  float ps = 0; for (int r = 0; r < 16; ++r) ps += p0[r]; for (int r = 0; r < 16; ++r) ps += p1[r];
  { auto rr = __builtin_amdgcn_permlane32_swap(__float_as_uint(ps), __float_as_uint(ps), false, false);
    ps = __uint_as_float(rr[0]) + __uint_as_float(rr[1]); }
  l_reg = l_reg * alpha + ps;
#define PK4(P, BASE, OUT) do { unsigned a0 = cvtpk(P[BASE + 0], P[BASE + 1]), a1 = cvtpk(P[BASE + 2], P[BASE + 3]);   \
    unsigned b0 = cvtpk(P[BASE + 4], P[BASE + 5]), b1 = cvtpk(P[BASE + 6], P[BASE + 7]);                              \
    auto r0 = __builtin_amdgcn_permlane32_swap(a0, b0, false, false); auto r1 = __builtin_amdgcn_permlane32_swap(a1, b1, false, false); \
    u32x4 w = {r0[0], r1[0], r0[1], r1[1]}; OUT = *reinterpret_cast<bf16x8*>(&w); } while (0)
  PK4(p0, 0, pa0); PK4(p0, 8, pa1); PK4(p1, 0, pa2); PK4(p1, 8, pa3);
#undef PK4
}
__device__ __forceinline__ void qkt(f32x16& p0, f32x16& p1, const bf16* Ks, const bf16x8* qr, int r32, int hi) {
  p0 = f32x16{}; p1 = f32x16{};
  for (int d0 = 0; d0 < 8; ++d0) { int cb = (d0 * 16 + hi * 8) * 2;
    bf16x8 b0 = *reinterpret_cast<const bf16x8*>((const char*)Ks + KSWZ(r32, cb));
    bf16x8 b1 = *reinterpret_cast<const bf16x8*>((const char*)Ks + KSWZ(32 + r32, cb));
    p0 = __builtin_amdgcn_mfma_f32_32x32x16_bf16(b0, qr[d0], p0, 0, 0, 0);
    p1 = __builtin_amdgcn_mfma_f32_32x32x16_bf16(b1, qr[d0], p1, 0, 0, 0); }
}
__device__ __forceinline__ int v_st(int k, int c) { const int kk = (k & ~0xC) | ((k & 4) << 1) | ((k & 8) >> 1); return ((kk >> 3) * 4 + (c >> 5)) * 512 + ((kk & 7) * 32 + (c & 31)) * 2; }
__device__ __forceinline__ int v_rd_base(int lane) { return ((lane & 3) << 3) | (((lane >> 2) & 3) << 6) | (((lane >> 4) & 1) << 5) | (((lane >> 5) & 1) << 8); }
constexpr int v_rd_off(int d0, int ks, int half) { return d0 * 512 + ks * 4096 + half * 2048; }
template <int OFF> __device__ __forceinline__ s16x4 tr_read(int vb) {
  s16x4 r; asm volatile("ds_read_b64_tr_b16 %0, %1 offset:%2" : "=&v"(r) : "v"(vb), "i"(OFF) : "memory"); return r;
}
template <int D0> __device__ __forceinline__ void pv_one(f32x16& od, int vb, bf16x8 pa0, bf16x8 pa1, bf16x8 pa2, bf16x8 pa3) {
  const s16x4 l0 = tr_read<v_rd_off(D0, 0, 0)>(vb), h0 = tr_read<v_rd_off(D0, 0, 1)>(vb), l1 = tr_read<v_rd_off(D0, 1, 0)>(vb), h1 = tr_read<v_rd_off(D0, 1, 1)>(vb);
  const s16x4 l2 = tr_read<v_rd_off(D0, 2, 0)>(vb), h2 = tr_read<v_rd_off(D0, 2, 1)>(vb), l3 = tr_read<v_rd_off(D0, 3, 0)>(vb), h3 = tr_read<v_rd_off(D0, 3, 1)>(vb);
  asm volatile("s_waitcnt lgkmcnt(0)" ::: "memory"); SBAR();
#define PK(L, H) (bf16x8){L[0], L[1], L[2], L[3], H[0], H[1], H[2], H[3]}
  od = __builtin_amdgcn_mfma_f32_32x32x16_bf16(pa0, PK(l0, h0), od, 0, 0, 0);
  od = __builtin_amdgcn_mfma_f32_32x32x16_bf16(pa1, PK(l1, h1), od, 0, 0, 0);
  od = __builtin_amdgcn_mfma_f32_32x32x16_bf16(pa2, PK(l2, h2), od, 0, 0, 0);
  od = __builtin_amdgcn_mfma_f32_32x32x16_bf16(pa3, PK(l3, h3), od, 0, 0, 0);
#undef PK
}
__device__ __forceinline__ void pv_d0(f32x16* o, int vb, bf16x8 pa0, bf16x8 pa1, bf16x8 pa2, bf16x8 pa3) {
  pv_one<0>(o[0], vb, pa0, pa1, pa2, pa3); pv_one<1>(o[1], vb, pa0, pa1, pa2, pa3); pv_one<2>(o[2], vb, pa0, pa1, pa2, pa3); pv_one<3>(o[3], vb, pa0, pa1, pa2, pa3);
}


__device__ __forceinline__ void attn_unit(const bfu* Qb, const bfu* __restrict__ Kh_, const bfu* __restrict__ Vh_, bfu* Ob,
                                          int t0, const float* __restrict__ qnorm, const float* __restrict__ tabc, const float* __restrict__ tabs, int seq, char* lds, const int tid) {
  const bf16* Kh = (const bf16*)Kh_; const bf16* Vh = (const bf16*)Vh_;
  using St = Stage<bf16>;
  const int wid = tid >> 6, lane = tid & 63, r32 = lane & 31, hi = lane >> 5;
  bf16* V_lds = (bf16*)lds; bf16* K_lds = (bf16*)(lds + 2 * SHM_V);
  float* ws = (float*)(lds + 2 * SHM_V + 2 * SHM_K) + wid * 64; float* li_l = ws; float* al_l = ws + 32;
  float m_reg = -1e30f, l_reg = 0; f32x16 o[4] = {}; bf16x8 qr[8];
#if DIAG == 3 || DIAG == 4
  { const bfu* Qw = Qb + (long)(wid * QBLK + r32) * LDQ + hi * 8;
#pragma unroll
    for (int d0 = 0; d0 < 8; ++d0) qr[d0] = *reinterpret_cast<const bf16x8*>(Qw + d0 * 16); }
#else
  {
    const bfu* Qw = Qb + (long)(wid * QBLK + r32) * LDQ + hi * 8;
    float qf[8][8]; float ss = 0.f;
#pragma unroll
    for (int d0 = 0; d0 < 8; ++d0) { const u32x4 w = *reinterpret_cast<const u32x4*>(Qw + d0 * 16);
#pragma unroll
      for (int j = 0; j < 4; ++j) { const float a = __builtin_bit_cast(float, w[j] << 16), b = __builtin_bit_cast(float, w[j] & 0xffff0000u); qf[d0][2 * j] = a; qf[d0][2 * j + 1] = b; ss += a * a + b * b; } }
    { auto rr = __builtin_amdgcn_permlane32_swap(__float_as_uint(ss), __float_as_uint(ss), false, false); ss = __uint_as_float(rr[0]) + __uint_as_float(rr[1]); }
    const float rstd = 1.0f / sqrtf(ss * (1.0f / 128.0f) + 1e-6f);
#pragma unroll
    for (int d0 = 0; d0 < 8; ++d0) { const float4 g0 = *reinterpret_cast<const float4*>(qnorm + d0 * 16 + hi * 8), g1 = *reinterpret_cast<const float4*>(qnorm + d0 * 16 + hi * 8 + 4);
      qf[d0][0] *= rstd * g0.x; qf[d0][1] *= rstd * g0.y; qf[d0][2] *= rstd * g0.z; qf[d0][3] *= rstd * g0.w; qf[d0][4] *= rstd * g1.x; qf[d0][5] *= rstd * g1.y; qf[d0][6] *= rstd * g1.z; qf[d0][7] *= rstd * g1.w; }
    const int t = t0 + wid * QBLK + r32, prow = t >> 6, pcol = t & 63;
#pragma unroll
    for (int a = 0; a < 2; ++a) { const int pos = a ? pcol : prow;
#pragma unroll
      for (int dp = 0; dp < 2; ++dp) { const int i0 = pos * 32 + dp * 16 + hi * 8;
#pragma unroll
        for (int j = 0; j < 8; ++j) { const float c = tabc[i0 + j], s = tabs[i0 + j]; const float x1 = qf[4 * a + dp][j], x2 = qf[4 * a + dp + 2][j];
          qf[4 * a + dp][j] = x1 * c - x2 * s; qf[4 * a + dp + 2][j] = x2 * c + x1 * s; } } }
#pragma unroll
    for (int d0 = 0; d0 < 8; ++d0) { u32x4 w = {cvtpk(qf[d0][0], qf[d0][1]), cvtpk(qf[d0][2], qf[d0][3]), cvtpk(qf[d0][4], qf[d0][5]), cvtpk(qf[d0][6], qf[d0][7])}; qr[d0] = *reinterpret_cast<bf16x8*>(&w); }
  }
#endif
  const int sr = tid >> 4, sc = (tid & 15) * 8, vst0 = v_st(sr, sc), vst1 = v_st(32 + sr, sc);
  const int vb0 = (int)(uintptr_t)V_lds + v_rd_base(lane);
  struct { typename St::T vs0, vs1, ks0, ks1; } sr_[SDEPTH];
#define SLOAD(i, k0) do { sr_[i].vs0 = St::ld8(&Vh[(long)((k0) + sr) * LDK + sc]); sr_[i].vs1 = St::ld8(&Vh[(long)((k0) + 32 + sr) * LDK + sc]); \
    sr_[i].ks0 = St::ld8(&Kh[(long)((k0) + sr) * LDK + sc]); sr_[i].ks1 = St::ld8(&Kh[(long)((k0) + 32 + sr) * LDK + sc]); } while (0)
#define SWRITE(b, i) do { *(bf16x8*)((char*)V_lds + (b) * SHM_V + vst0) = St::tobf(sr_[i].vs0);          \
    *(bf16x8*)((char*)V_lds + (b) * SHM_V + vst1) = St::tobf(sr_[i].vs1); int kc = sc * 2;               \
    *(bf16x8*)((char*)K_lds + (b) * SHM_K + KSWZ(sr, kc)) = St::tobf(sr_[i].ks0);                       \
    *(bf16x8*)((char*)K_lds + (b) * SHM_K + KSWZ(32 + sr, kc)) = St::tobf(sr_[i].ks1); } while (0)
#define SWAIT() do { if constexpr (SDEPTH == 2) asm volatile("s_waitcnt vmcnt(4)" ::: "memory"); else asm volatile("s_waitcnt vmcnt(0)" ::: "memory"); } while (0)
#define RESC(a) do { if (__any((a) < 1.f)) { if (hi == 0) al_l[r32] = (a); asm volatile("s_waitcnt lgkmcnt(0)" ::: "memory"); \
    for (int d = 0; d < 4; ++d) for (int r = 0; r < 16; ++r) o[d][r] *= al_l[crow(r, hi)]; } } while (0)
  f32x16 pA0, pA1, pB0, pB1; float mnA, mnB, alA, alB; bf16x8 pa0, pa1, pa2, pa3; const int NT = seq / KVBLK;
  constexpr int SE = 0, SO = SDEPTH - 1;
  SLOAD(SE, 0); asm volatile("s_waitcnt vmcnt(0)" ::: "memory"); SWRITE(0, SE); __syncthreads();
  qkt(pA0, pA1, K_lds, qr, r32, hi); partialSM(pA0, pA1, m_reg, mnA, alA);
  SLOAD(SO, KVBLK); if constexpr (SDEPTH == 2) { if (2 < NT) SLOAD(SE, 2 * KVBLK); }
  SWAIT(); SWRITE(1, SO); __syncthreads();
  for (int j = 1; j + 1 < NT; j += 2) {
    SBAR(); qkt(pB0, pB1, (bf16*)((char*)K_lds + SHM_K), qr, r32, hi);
    finishSM(pA0, pA1, alA, l_reg, pa0, pa1, pa2, pa3); SBAR();
    SLOAD(SO, (j + SDEPTH) * KVBLK); SBAR();
    pv_d0(o, vb0, pa0, pa1, pa2, pa3); partialSM(pB0, pB1, m_reg, mnB, alB);
    __syncthreads(); SWAIT(); SWRITE(0, SE);
    RESC(alB); __syncthreads();
    SBAR(); qkt(pA0, pA1, K_lds, qr, r32, hi);
    finishSM(pB0, pB1, alB, l_reg, pa0, pa1, pa2, pa3); SBAR();
    if (SDEPTH == 1 || j + 3 < NT) SLOAD(SE, (j + 1 + SDEPTH) * KVBLK); SBAR();
    pv_d0(o, vb0 + (int)SHM_V, pa0, pa1, pa2, pa3); partialSM(pA0, pA1, m_reg, mnA, alA);
    __syncthreads(); SWAIT(); SWRITE(1, SO);
    RESC(alA); __syncthreads();
  }
  SBAR(); qkt(pB0, pB1, (bf16*)((char*)K_lds + SHM_K), qr, r32, hi);
  finishSM(pA0, pA1, alA, l_reg, pa0, pa1, pa2, pa3); SBAR();
  pv_d0(o, vb0, pa0, pa1, pa2, pa3); partialSM(pB0, pB1, m_reg, mnB, alB);
  __syncthreads(); RESC(alB);
  finishSM(pB0, pB1, alB, l_reg, pa0, pa1, pa2, pa3); SBAR();
  pv_d0(o, vb0 + (int)SHM_V, pa0, pa1, pa2, pa3);
  if (hi == 0) li_l[r32] = l_reg; asm volatile("s_waitcnt lgkmcnt(0)" ::: "memory");
  float rli[16];
#pragma unroll
  for (int r = 0; r < 16; ++r) rli[r] = __builtin_amdgcn_rcpf(li_l[crow(r, hi)]);
  __syncthreads();
  { int et = tid; asm volatile("" : "+v"(et));
    const int ln = et & 63, ewid = et >> 6, er32 = ln & 31, ehi = ln >> 5;
    bfu* stg = (bfu*)lds + ewid * 4096; bfu* sw = stg + (4 * ehi) * 128 + er32;
#pragma unroll
    for (int r = 0; r < 16; ++r) { const int ro = (r & 3) + 8 * (r >> 2);
#pragma unroll
      for (int d0 = 0; d0 < 4; ++d0) sw[ro * 128 + d0 * 32] = (bfu)f2bf(o[d0][r] * rli[r]); }
    asm volatile("s_waitcnt lgkmcnt(0)" ::: "memory");
    const bfu* sp = stg + (ln >> 4) * 128 + (ln & 15) * 8;
    bfu* Ow = Ob + (long)(ewid * QBLK + (ln >> 4)) * LDO + (ln & 15) * 8;
#pragma unroll
    for (int i = 0; i < 8; ++i) { const u32x4 v = *(const u32x4*)(sp + i * 512); *(u32x4*)(Ow + (long)i * 4 * LDO) = v; }
  }
  __syncthreads();
#undef SLOAD
#undef SWRITE
#undef SWAIT
#undef RESC
}
#undef SBAR
#undef KSWZ
}
#define XB_TMO      128
#define XB_XCNT(j)  (256  + 64 * (j))
#define XB_XSUB(j)  (1280 + 64 * (j))
#define XB_XGEN(j)  (2304 + 64 * (j))
#define XB_TOP      3328
#define XB_TOPGEN   3392
#define XCD_BAR_WORDS 3456
#define XB_SPIN_CAP (1u << 18)

__device__ __forceinline__ unsigned xb_ld(unsigned* p)              { return __hip_atomic_load(p, __ATOMIC_RELAXED, __HIP_MEMORY_SCOPE_AGENT); }
__device__ __forceinline__ unsigned xb_add(unsigned* p, unsigned v) { return __hip_atomic_fetch_add(p, v, __ATOMIC_RELAXED, __HIP_MEMORY_SCOPE_AGENT); }
__device__ __forceinline__ unsigned xb_xcc_id() { return (unsigned)__builtin_amdgcn_s_getreg((3 << 11) | 20) & 0xFu; }
#define XB_SPIN(cond, bar) do { unsigned _sp = 0; while (cond) { __builtin_amdgcn_s_sleep(1); \
    if ((++_sp & 255u) == 0u) { if (xb_ld(&(bar)[XB_TMO])) break; if (_sp > XB_SPIN_CAP) { atomicAdd(&(bar)[XB_TMO], 1u); break; } } } } while (0)

struct XcdBarrier {
    unsigned* bar; unsigned x;
    volatile LAS unsigned* st;
};

__device__ __forceinline__ XcdBarrier xcd_barrier_post(unsigned* bar, volatile LAS unsigned* st) {
    XcdBarrier b; b.bar = bar; b.x = xb_xcc_id(); b.st = st;
    if (threadIdx.x == 0) (void)xb_add(&bar[XB_XCNT(b.x)], 1u);
    return b;
}
__device__ __forceinline__ void xcd_barrier_complete(unsigned* bar, unsigned x, unsigned& nloc, unsigned& nx) {
    const unsigned G = gridDim.x * gridDim.y * gridDim.z;
    unsigned sum, cnt, mine, sp = 0u;
    for (;;) {
        sum = 0u; cnt = 0u; mine = 0u;
#pragma unroll
        for (unsigned j = 0; j < 16; ++j) { const unsigned c = xb_ld(&bar[XB_XCNT(j)]); sum += c; cnt += (c > 0u) ? 1u : 0u; mine = (j == x) ? c : mine; }
        if (sum == G) break;
        __builtin_amdgcn_s_sleep(1);
        if ((++sp & 255u) == 0u) { if (xb_ld(&bar[XB_TMO])) break; if (sp > XB_SPIN_CAP) { atomicAdd(&bar[XB_TMO], 1u); break; } }
    }
    nloc = mine > 0u ? mine : 1u; nx = cnt > 0u ? cnt : 1u;
}

__device__ __forceinline__ void xcd_barrier(const XcdBarrier& b) {
    asm volatile("s_waitcnt vmcnt(0)" ::: "memory");
    __syncthreads();
    if (threadIdx.x == 0) {
        unsigned* bar = b.bar;
        __builtin_amdgcn_s_waitcnt(0);
        unsigned nloc = b.st[0], nx = b.st[1];
        if (nloc == 0u) { xcd_barrier_complete(bar, b.x, nloc, nx); b.st[0] = nloc; b.st[1] = nx; }
        const unsigned old = xb_add(&bar[XB_XSUB(b.x)], 1u);
        const unsigned gen = old / nloc;
        if (old + 1u == (gen + 1u) * nloc) {
            __builtin_amdgcn_fence(__ATOMIC_RELEASE, "agent");
            asm volatile("s_waitcnt vmcnt(0)" ::: "memory");
            const unsigned og = xb_add(&bar[XB_TOP], 1u);
            const unsigned tg = og / nx;
            if (og + 1u == (tg + 1u) * nx) xb_add(&bar[XB_TOPGEN], 1u);
            else XB_SPIN(xb_ld(&bar[XB_TOPGEN]) == tg, bar);
            __builtin_amdgcn_fence(__ATOMIC_ACQUIRE, "agent");
            xb_add(&bar[XB_XGEN(b.x)], 1u);
            asm volatile("s_waitcnt vmcnt(0)" ::: "memory");
        } else {
            XB_SPIN(xb_ld(&bar[XB_XGEN(b.x)]) == gen, bar);
            __builtin_amdgcn_fence(__ATOMIC_ACQUIRE, "agent");
            asm volatile("s_waitcnt vmcnt(0)" ::: "memory");
        }
    }
    __syncthreads();
}

namespace gla {
typedef short bf16x8 __attribute__((ext_vector_type(8)));
typedef short s16x4 __attribute__((ext_vector_type(4)));
typedef float f32x4 __attribute__((ext_vector_type(4)));
typedef unsigned u32x4 __attribute__((ext_vector_type(4)));
typedef unsigned u32x2 __attribute__((ext_vector_type(2)));
typedef short v4i16_t __attribute__((ext_vector_type(4)));
constexpr int QT_STR = 272, V_STR = 544, S_STR = 144, O_STR = 528;
constexpr int L_LA = 0, L_QT = 32768, L_KT = L_QT + 64 * QT_STR, L_V = L_KT + 64 * QT_STR, L_S = L_V + 64 * V_STR, L_GR = L_S + 64 * S_STR, L_EL = L_GR + 4096, L_O = L_EL + 512, L_W = L_O + 64 * O_STR, L_END = L_W + 17 * 512;
static_assert(L_END <= MISC_OFF - 320, "gla lds map");
__device__ __forceinline__ unsigned pk(float lo, float hi) { typedef float f2 __attribute__((ext_vector_type(2))); typedef __bf16 b2 __attribute__((ext_vector_type(2))); const f2 v = {lo, hi}; return __builtin_bit_cast(unsigned, __builtin_convertvector(v, b2)); }
__device__ __forceinline__ s16x4 trr(LAS const unsigned char* p) { return __builtin_bit_cast(s16x4, __builtin_amdgcn_ds_read_tr16_b64_v4i16((LAS v4i16_t*)p)); }
#define GLA_BAR() __syncthreads()
#ifdef TIME_PHASE
#define GT0() const unsigned long long gt0_ = __builtin_amdgcn_s_memrealtime()
#define GTV(n) const unsigned long long n = __builtin_amdgcn_s_memrealtime()
#define GSPINV(bit, n) do { if ((TIME_PHASE >> (bit)) & 1) { const unsigned long long t1_ = __builtin_amdgcn_s_memrealtime(), dt_ = t1_ - (n); while (__builtin_amdgcn_s_memrealtime() - t1_ < dt_) __builtin_amdgcn_s_sleep(2); } } while (0)
#define GSPIN(bit) do { if ((TIME_PHASE >> (bit)) & 1) { const unsigned long long t1_ = __builtin_amdgcn_s_memrealtime(), dt_ = t1_ - gt0_; while (__builtin_amdgcn_s_memrealtime() - t1_ < dt_) __builtin_amdgcn_s_sleep(2); } } while (0)
#else
#define GT0() do {} while (0)
#define GTV(n) do {} while (0)
#define GSPINV(bit, n) do {} while (0)
#define GSPIN(bit) do {} while (0)
#endif

struct Io {
    const float* GR; const bfu* GQK; const bfu* GV; const float* wgk; const float* bgk;
    float* ST; float* TOT;
    bfu* OF; const bfu* UA; const bfu* SG; bfu* AQ; const float* gnorm;
};

template <int MODE>
__device__ __forceinline__ void pass(LAS unsigned char* lds, const Io& io, int b, int h, int seg, int dir, int tid0) {
    const int wave = __builtin_amdgcn_readfirstlane(tid0 >> 6);
    int tid = tid0; int lane = tid & 63, li = lane & 15, g = lane >> 4;
    int d = wave * 16 + li, rq = g;
    for (int i = tid; i < 17 * 128; i += 512) { const int j = i >> 7, dd = i & 127; *(LAS float*)(lds + L_W + i * 4) = (j < 16) ? io.wgk[j * 512 + h * 128 + dd] : io.bgk[h * 128 + dd]; }
    f32x4 st[8][2];
    if (MODE == 0) {
#pragma unroll
        for (int t = 0; t < 16; ++t) st[t >> 1][t & 1] = (f32x4){0.f, 0.f, 0.f, 0.f};
    } else {
#pragma unroll
        for (int t = 0; t < 16; ++t)
#pragma unroll
            for (int r = 0; r < 4; ++r) st[t >> 1][t & 1][r] = io.ST[((wave * 16 + t) * 4 + r) * 64 + lane];
    }
    float tot = 0.f;
    const size_t seg0 = (size_t)b * SEQ + (size_t)seg * 256;
    int gr_r = tid >> 2, gr_j = (tid & 3) * 4;
    if (tid < 256) { const size_t t = seg0 + (dir ? 3 : 0) * 64 + (dir ? 63 - gr_r : gr_r); *(LAS f32x4*)(lds + L_GR + gr_r * 64 + gr_j * 4) = *(const f32x4*)(io.GR + t * 32 + dir * 16 + gr_j); }
    GLA_BAR();
    for (int cc = 0; cc < 4; ++cc) {
        asm volatile("" : "+v"(tid));
        lane = tid & 63; li = lane & 15; g = lane >> 4; d = wave * 16 + li; rq = g; gr_r = tid >> 2; gr_j = (tid & 3) * 4;
        const int c = dir ? 3 - cc : cc; const size_t tok0 = seg0 + c * 64;
        u32x4 qv[2], kv[2], vv[4];
#pragma unroll
        for (int i = 0; i < 2; ++i) { const int p = tid + 512 * i, r = p >> 4, d0 = (p & 15) * 8; const size_t t = tok0 + (dir ? 63 - r : r);
            if (MODE != 0) qv[i] = *(const u32x4*)(io.GQK + t * 1024 + h * 128 + d0);
            kv[i] = *(const u32x4*)(io.GQK + t * 1024 + 512 + h * 128 + d0); }
#pragma unroll
        for (int i = 0; i < 4; ++i) { const int p = tid + 512 * i, r = p >> 5, c0 = (p & 31) * 8; const size_t t = tok0 + (dir ? 63 - r : r);
            vv[i] = *(const u32x4*)(io.GV + t * 1024 + h * 256 + c0); }
        { GT0(); float la[16]; float run = 0.f; float w[16];
#pragma unroll
          for (int j = 0; j < 16; ++j) w[j] = *(LAS const float*)(lds + L_W + (j * 128 + d) * 4);
          const float bias = *(LAS const float*)(lds + L_W + (16 * 128 + d) * 4);
#pragma unroll
          for (int i = 0; i < 16; ++i) { const int r = rq * 16 + i; float x = bias;
            const f32x4 g0 = *(LAS const f32x4*)(lds + L_GR + r * 64), g1 = *(LAS const f32x4*)(lds + L_GR + r * 64 + 16), g2 = *(LAS const f32x4*)(lds + L_GR + r * 64 + 32), g3 = *(LAS const f32x4*)(lds + L_GR + r * 64 + 48);
            x += g0[0] * w[0] + g0[1] * w[1] + g0[2] * w[2] + g0[3] * w[3] + g1[0] * w[4] + g1[1] * w[5] + g1[2] * w[6] + g1[3] * w[7]
               + g2[0] * w[8] + g2[1] * w[9] + g2[2] * w[10] + g2[3] * w[11] + g3[0] * w[12] + g3[1] * w[13] + g3[2] * w[14] + g3[3] * w[15];
            const float e = __builtin_amdgcn_exp2f(-1.4426950408889634f * fabsf(x));
            const float ls = -(fmaxf(-x, 0.f) + 0.6931471805599453f * __builtin_amdgcn_logf(1.0f + e)) * 0.0625f;
            run += ls; la[i] = run; }
          const float t0 = __shfl(run, li), t1 = __shfl(run, 16 + li), t2 = __shfl(run, 32 + li);
          const float off = (rq > 0 ? t0 : 0.f) + (rq > 1 ? t1 : 0.f) + (rq > 2 ? t2 : 0.f);
#pragma unroll
          for (int i = 0; i < 16; ++i) *(LAS float*)(lds + L_LA + ((rq * 16 + i) * 128 + d) * 4) = la[i] + off;
          if (rq == 3) { const float last = la[15] + off; *(LAS float*)(lds + L_EL + d * 4) = __builtin_amdgcn_exp2f(1.4426950408889634f * last); tot += last; } GSPIN(8); }
        GLA_BAR();
        GTV(gtB);
        f32x4 grn = {0.f, 0.f, 0.f, 0.f};
        if (cc < 3 && tid < 256) { const int cn = dir ? 2 - cc : cc + 1; const size_t t = seg0 + cn * 64 + (dir ? 63 - gr_r : gr_r); grn = *(const f32x4*)(io.GR + t * 32 + dir * 16 + gr_j); }
#pragma unroll
        for (int i = 0; i < 2; ++i) { const int p = tid + 512 * i, r = p >> 4, d0 = (p & 15) * 8;
            const f32x4 c0 = *(LAS const f32x4*)(lds + L_LA + (r * 128 + d0) * 4), c1 = *(LAS const f32x4*)(lds + L_LA + (r * 128 + d0 + 4) * 4);
            float ei[8];
#pragma unroll
            for (int j = 0; j < 4; ++j) { ei[j] = __builtin_amdgcn_exp2f(-1.4426950408889634f * c0[j]); ei[4 + j] = __builtin_amdgcn_exp2f(-1.4426950408889634f * c1[j]); }
            u32x4 ko;
#pragma unroll
            for (int j = 0; j < 4; ++j) ko[j] = pk(bflo(kv[i][j]) * ei[2 * j], bfhi(kv[i][j]) * ei[2 * j + 1]);
            *(LAS u32x4*)(lds + L_KT + r * QT_STR + d0 * 2) = ko;
            if (MODE != 0) { float e[8];
#pragma unroll
                for (int j = 0; j < 4; ++j) { e[j] = __builtin_amdgcn_exp2f(1.4426950408889634f * c0[j]); e[4 + j] = __builtin_amdgcn_exp2f(1.4426950408889634f * c1[j]); }
                u32x4 qo;
#pragma unroll
                for (int j = 0; j < 4; ++j) qo[j] = pk(bflo(qv[i][j]) * e[2 * j], bfhi(qv[i][j]) * e[2 * j + 1]);
                *(LAS u32x4*)(lds + L_QT + r * QT_STR + d0 * 2) = qo; } }
#pragma unroll
        for (int i = 0; i < 4; ++i) { const int p = tid + 512 * i, r = p >> 5, c0 = (p & 31) * 8; *(LAS u32x4*)(lds + L_V + r * V_STR + c0 * 2) = vv[i]; }
        GSPINV(9, gtB);
        GLA_BAR();
        GTV(gtC);
        f32x4 acc[4][2];
        if (MODE != 0) {
            const int ti = wave >> 1;
#pragma unroll
            for (int jj = 0; jj < 2; ++jj) { const int tj = 2 * (wave & 1) + jj; f32x4 s = {0.f, 0.f, 0.f, 0.f};
                if (tj <= ti) {
#pragma unroll
                    for (int ks = 0; ks < 4; ++ks) { const bf16x8 a = *(LAS const bf16x8*)(lds + L_QT + (16 * ti + li) * QT_STR + ks * 64 + g * 16), bb = *(LAS const bf16x8*)(lds + L_KT + (16 * tj + li) * QT_STR + ks * 64 + g * 16);
                        s = __builtin_amdgcn_mfma_f32_16x16x32_bf16(a, bb, s, 0, 0, 0); } }
#pragma unroll
                for (int r = 0; r < 4; ++r) { const int ig = 16 * ti + 4 * g + r, jg = 16 * tj + li; const bool keep = dir ? (ig > jg) : (ig >= jg);
                    *(LAS unsigned short*)(lds + L_S + ig * S_STR + jg * 2) = (unsigned short)(pk(keep ? s[r] : 0.f, 0.f) & 0xffffu); } }
        }
        bf16x8 bv[2][2];
#pragma unroll
        for (int ks = 0; ks < 2; ++ks)
#pragma unroll
            for (int tc = 0; tc < 2; ++tc) { const LAS unsigned char* p = lds + L_V + (32 * ks + 8 * g + (li >> 2)) * V_STR + (wave * 32 + 16 * tc + 4 * (li & 3)) * 2;
                const s16x4 lo = trr(p), hi = trr(p + 4 * V_STR); bv[ks][tc] = (bf16x8){lo[0], lo[1], lo[2], lo[3], hi[0], hi[1], hi[2], hi[3]}; }
        u32x2 ef[8], eu[8], em[8];
        if (MODE != 0) {
#pragma unroll
            for (int mi = 0; mi < 4; ++mi) { acc[mi][0] = (f32x4){0.f, 0.f, 0.f, 0.f}; acc[mi][1] = (f32x4){0.f, 0.f, 0.f, 0.f}; }
#pragma unroll
            for (int ks = 0; ks < 4; ++ks) { bf16x8 bs[2];
#pragma unroll
                for (int tc = 0; tc < 2; ++tc) { u32x4 u; u[0] = pk(st[2 * ks][tc][0], st[2 * ks][tc][1]); u[1] = pk(st[2 * ks][tc][2], st[2 * ks][tc][3]); u[2] = pk(st[2 * ks + 1][tc][0], st[2 * ks + 1][tc][1]); u[3] = pk(st[2 * ks + 1][tc][2], st[2 * ks + 1][tc][3]); bs[tc] = __builtin_bit_cast(bf16x8, u); }
#pragma unroll
                for (int mi = 0; mi < 4; ++mi) { const u32x2 a0 = *(LAS const u32x2*)(lds + L_QT + (16 * mi + li) * QT_STR + (32 * ks + 4 * g) * 2), a1 = *(LAS const u32x2*)(lds + L_QT + (16 * mi + li) * QT_STR + (32 * ks + 16 + 4 * g) * 2);
                    const u32x4 au = {a0[0], a0[1], a1[0], a1[1]}; const bf16x8 a = __builtin_bit_cast(bf16x8, au);
                    acc[mi][0] = __builtin_amdgcn_mfma_f32_16x16x32_bf16(a, bs[0], acc[mi][0], 0, 0, 0); acc[mi][1] = __builtin_amdgcn_mfma_f32_16x16x32_bf16(a, bs[1], acc[mi][1], 0, 0, 0); } }
            if (MODE == 2) {
#pragma unroll
                for (int i = 0; i < 8; ++i) { const int r = wave * 8 + i; const size_t t = tok0 + (dir ? 63 - r : r), base = t * 1024 + h * 256 + 4 * lane;
                    ef[i] = *(const u32x2*)(io.OF + base); eu[i] = *(const u32x2*)(io.UA + base); const u32x2 sg = *(const u32x2*)(io.SG + base), mb = *(const u32x2*)(io.AQ + base);
                    em[i][0] = pk(bflo(mb[0]) * bflo(sg[0]), bfhi(mb[0]) * bfhi(sg[0])); em[i][1] = pk(bflo(mb[1]) * bflo(sg[1]), bfhi(mb[1]) * bfhi(sg[1])); }
            }
        }
#pragma unroll
        for (int ks = 0; ks < 2; ++ks)
#pragma unroll
            for (int tr = 0; tr < 8; ++tr) { const LAS unsigned char* p = lds + L_KT + (32 * ks + 8 * g + (li >> 2)) * QT_STR + (16 * tr + 4 * (li & 3)) * 2;
                const s16x4 lo = trr(p), hi = trr(p + 4 * QT_STR); const bf16x8 a = (bf16x8){lo[0], lo[1], lo[2], lo[3], hi[0], hi[1], hi[2], hi[3]};
                st[tr][0] = __builtin_amdgcn_mfma_f32_16x16x32_bf16(a, bv[ks][0], st[tr][0], 0, 0, 0); st[tr][1] = __builtin_amdgcn_mfma_f32_16x16x32_bf16(a, bv[ks][1], st[tr][1], 0, 0, 0); }
#pragma unroll
        for (int tr = 0; tr < 8; ++tr) { const f32x4 el = *(LAS const f32x4*)(lds + L_EL + (16 * tr + 4 * g) * 4); st[tr][0] *= el; st[tr][1] *= el; }
        if (cc < 3 && tid < 256) *(LAS f32x4*)(lds + L_GR + gr_r * 64 + gr_j * 4) = grn;
        GSPINV(10, gtC);
        GLA_BAR();
        GTV(gtD);
        if (MODE != 0) {
#pragma unroll
            for (int ks = 0; ks < 2; ++ks)
#pragma unroll
                for (int mi = 0; mi < 4; ++mi) { const bf16x8 a = *(LAS const bf16x8*)(lds + L_S + (16 * mi + li) * S_STR + ks * 64 + g * 16);
                    acc[mi][0] = __builtin_amdgcn_mfma_f32_16x16x32_bf16(a, bv[ks][0], acc[mi][0], 0, 0, 0); acc[mi][1] = __builtin_amdgcn_mfma_f32_16x16x32_bf16(a, bv[ks][1], acc[mi][1], 0, 0, 0); }
#pragma unroll
            for (int mi = 0; mi < 4; ++mi)
#pragma unroll
                for (int tc = 0; tc < 2; ++tc)
#pragma unroll
                    for (int r = 0; r < 4; ++r) *(LAS unsigned short*)(lds + L_O + (16 * mi + 4 * g + r) * O_STR + (wave * 32 + 16 * tc + li) * 2) = (unsigned short)(pk(acc[mi][tc][r], 0.f) & 0xffffu);
            GLA_BAR();
            if (MODE == 1) {
#pragma unroll
                for (int i = 0; i < 4; ++i) { const int p = tid + 512 * i, r = p >> 5, c0 = (p & 31) * 8; const size_t t = tok0 + (dir ? 63 - r : r);
                    *(u32x4*)(io.OF + t * 1024 + h * 256 + c0) = *(LAS const u32x4*)(lds + L_O + r * O_STR + c0 * 2); }
            } else {
                const f32x4 gn = *(const f32x4*)(io.gnorm + 4 * lane);
#pragma unroll
                for (int i = 0; i < 8; ++i) { const int r = wave * 8 + i; const size_t t = tok0 + (dir ? 63 - r : r), base = t * 1024 + h * 256 + 4 * lane;
                    const u32x2 ob = *(LAS const u32x2*)(lds + L_O + r * O_STR + lane * 8);
                    const float o0 = bflo(ob[0]) + bflo(ef[i][0]), o1 = bfhi(ob[0]) + bfhi(ef[i][0]), o2 = bflo(ob[1]) + bflo(ef[i][1]), o3 = bfhi(ob[1]) + bfhi(ef[i][1]);
                    const float rstd = 1.0f / sqrtf(wave_sum_dpp((o0 * o0 + o1 * o1) + (o2 * o2 + o3 * o3)) * (1.f / 256.f) + 1e-6f);
                    u32x2 wv; wv[0] = pk(o0 * rstd * gn[0] * bflo(eu[i][0]) + bflo(em[i][0]), o1 * rstd * gn[1] * bfhi(eu[i][0]) + bfhi(em[i][0]));
                    wv[1] = pk(o2 * rstd * gn[2] * bflo(eu[i][1]) + bflo(em[i][1]), o3 * rstd * gn[3] * bfhi(eu[i][1]) + bfhi(em[i][1]));
                    *(u32x2*)(io.AQ + base) = wv; }
            }
        }
        GSPINV(11, gtD);
    }
    if (MODE == 0) {
#pragma unroll
        for (int t = 0; t < 16; ++t)
#pragma unroll
            for (int r = 0; r < 4; ++r) io.ST[((wave * 16 + t) * 4 + r) * 64 + lane] = st[t >> 1][t & 1][r];
        if (rq == 3) io.TOT[d] = tot;
    }
    GLA_BAR();
}
}

__device__ __forceinline__ int fresh_tid(int wave_s) { int l; asm volatile("v_mbcnt_lo_u32_b32 %0, -1, 0\n\tv_mbcnt_hi_u32_b32 %0, -1, %0" : "=v"(l)); return wave_s * 64 + l; }
#define PHASE_IDS const int tid_ = fresh_tid(C.wave_s); const int lane_ = tid_ & 63; const int wave_ = __builtin_amdgcn_readfirstlane(tid_ >> 6); (void)lane_; (void)wave_
struct Ctx {
    LAS unsigned char* lds; char* ldsg; int vcu, G, wave_s;
    const float *x, *mix_norm, *w_in, *wgk_f, *bgk_f, *wgk_b, *bgk_b, *gla_norm, *q_norm, *k_norm, *b_gate, *w_o, *ffn_norm, *w_gu, *w_dn, *final_norm;
    float* out; unsigned char* ws;
};
#define WSP(T, off) ((T*)(C.ws + (off)))

__device__ __forceinline__ int src_col_in(int rho0) {
    const int tile = rho0 >> 8, c = rho0 & 255;
    if (tile < 8) return rho0;
    if (tile < 16) { const int u = tile - 8; return c < 128 ? 2048 + 128 * u + c : 4640 + 128 * u + (c - 128); }
    if (tile < 20) return 3104 + (tile - 16) * 256 + c;
    if (tile == 20) return 4128 + c;
    if (tile == 21) return 4384 + c;
    if (tile < 26) return 5664 + (tile - 22) * 256 + c;
    return c < 32 ? 3072 + c : -1;
}
__device__ __forceinline__ int src_col_gu(int rho0) { const int tile = rho0 >> 8, c = rho0 & 255; return c < 128 ? 128 * tile + c : 2816 + 128 * tile + (c - 128); }
__device__ __forceinline__ void p0_transpose_item(const float* W, int K, int N, bfu* WT, int dr0, int sc0, int k0, const float* g, LAS float* scr, int lane) {
    if (sc0 >= 0) {
        float v[32];
#pragma unroll
        for (int i = 0; i < 32; ++i) v[i] = W[(size_t)(k0 + 2 * i + (lane >> 5)) * N + sc0 + (lane & 31)];
        if (g) {
#pragma unroll
            for (int i = 0; i < 32; ++i) v[i] *= g[k0 + 2 * i + (lane >> 5)];
        }
#pragma unroll
        for (int i = 0; i < 32; ++i) scr[(2 * i + (lane >> 5)) * 33 + (lane & 31)] = v[i];
    } else {
#pragma unroll 8
        for (int i = 0; i < 32; ++i) { const int kk = 2 * i + (lane >> 5); scr[kk * 33 + (lane & 31)] = 0.f; }
    }
    LDS_WAIT(); asm volatile("" ::: "memory");
    const int c = lane & 7;
#pragma unroll
    for (int j = 0; j < 4; ++j) { const int n = (lane >> 3) + 8 * j; const LAS float* s = scr + (8 * c) * 33 + n;
        v4u o; o.x = pk2(s[0 * 33], s[1 * 33]); o.y = pk2(s[2 * 33], s[3 * 33]); o.z = pk2(s[4 * 33], s[5 * 33]); o.w = pk2(s[6 * 33], s[7 * 33]);
        *(GAS v4u*)(WT + (size_t)(dr0 + n) * K + k0 + 8 * c) = o; }
    LDS_WAIT(); asm volatile("" ::: "memory");
}
__device__ __forceinline__ void phase_prologue(const Ctx& C) {
    PHASE_IDS;
    LAS float* scr = (LAS float*)(C.lds + wave_ * 16384);
    const int gw = C.vcu * NWAVES + wave_, NGW = C.G * NWAVES;
    constexpr int I_IN = 16 * (NIN / 32), I_O = 16 * 32, I_GU = 16 * (2 * DFF / 32), I_DN = (DFF / 64) * 32;
    for (int it = gw; it < I_IN + I_O + I_GU + I_DN; it += NGW) {
        int r = it;
        if (r < I_IN) { const int kb = r / (NIN / 32), nb = r % (NIN / 32); p0_transpose_item(C.w_in, DM, DIN, WSP(bfu, WS_WIN), nb * 32, src_col_in(nb * 32), kb * 64, nullptr, scr, lane_); continue; } r -= I_IN;
        if (r < I_O) { const int kb = r / 32, nb = r % 32; p0_transpose_item(C.w_o, DM, DM, WSP(bfu, WS_WO), nb * 32, nb * 32, kb * 64, nullptr, scr, lane_); continue; } r -= I_O;
        if (r < I_GU) { const int kb = r / (2 * DFF / 32), nb = r % (2 * DFF / 32); p0_transpose_item(C.w_gu, DM, 2 * DFF, WSP(bfu, WS_WGU), nb * 32, src_col_gu(nb * 32), kb * 64, C.ffn_norm, scr, lane_); continue; } r -= I_GU;
        { const int kb = r / 32, nb = r % 32; p0_transpose_item(C.w_dn, DFF, DM, WSP(bfu, WS_WDN), nb * 32, nb * 32, kb * 64, nullptr, scr, lane_); }
    }
    bfu* H = (bfu*)C.out;
    for (int m0 = gw; m0 < TOK; m0 += 2 * NGW) {
        float4 v[2][4]; float s[2] = {0.f, 0.f};
#pragma unroll
        for (int q = 0; q < 2; ++q) { const int m = m0 + q * NGW; if (m < TOK) { const float4* xr = (const float4*)(C.x + (size_t)m * DM) + lane_;
#pragma unroll
            for (int j = 0; j < 4; ++j) v[q][j] = xr[64 * j]; } }
#pragma unroll
        for (int q = 0; q < 2; ++q) { const int m = m0 + q * NGW; if (m < TOK) {
#pragma unroll
            for (int j = 0; j < 4; ++j) s[q] += (v[q][j].x * v[q][j].x + v[q][j].y * v[q][j].y) + (v[q][j].z * v[q][j].z + v[q][j].w * v[q][j].w);
            const float rstd = 1.0f / sqrtf(wave_sum(s[q]) * (1.f / DM) + EPS);
            unsigned long long* o8 = (unsigned long long*)(H + (size_t)m * DM) + lane_;
#pragma unroll
            for (int j = 0; j < 4; ++j) { const float4 g = *((const float4*)C.mix_norm + lane_ + 64 * j);
                o8[64 * j] = (unsigned long long)pk2(v[q][j].x * rstd * g.x, v[q][j].y * rstd * g.y) | ((unsigned long long)pk2(v[q][j].z * rstd * g.z, v[q][j].w * rstd * g.w) << 32); } } }
    }
    if (C.vcu == 0) { float* tc = WSP(float, WS_ROPE); float* ts = tc + 2048;
        for (int i = tid_; i < 2048; i += NWAVES * 64) { const int pos = i >> 5, f = i & 31; const float fr = powf(10000.0f, -(float)(2 * f) / 64.0f); const float ang = (float)pos * fr; tc[i] = cosf(ang); ts[i] = sinf(ang); } }
}
__device__ __forceinline__ void phase_knorm(const Ctx& C) {
    PHASE_IDS;
    const int gw = C.vcu * NWAVES + wave_, NGW = C.G * NWAVES; const float* tc = WSP(float, WS_ROPE); const float* ts = tc + 2048; bfu* AKV = WSP(bfu, WS_AKV);
    const int l31 = lane_ & 31;
    const float4 g = *((const float4*)C.k_norm + l31);
    for (int row = gw; row < TOK; row += NGW) {
        v2u* p = (v2u*)(AKV + (size_t)row * 512 + (lane_ >> 5) * 128) + l31; const v2u w = *p;
        float xv[4] = {bflo(w.x), bfhi(w.x), bflo(w.y), bfhi(w.y)};
        float ss = (xv[0] * xv[0] + xv[1] * xv[1]) + (xv[2] * xv[2] + xv[3] * xv[3]);
#pragma unroll
        for (int o = 1; o < 32; o <<= 1) ss += __shfl_xor(ss, o);
        const float rstd = 1.0f / sqrtf(ss * (1.f / 128.f) + EPS);
        xv[0] *= rstd * g.x; xv[1] *= rstd * g.y; xv[2] *= rstd * g.z; xv[3] *= rstd * g.w;
        const int t = row & (SEQ - 1); const int dim0 = 4 * l31; const int pos = (dim0 >> 6) ? (t & 63) : (t >> 6); const int i0 = pos * 32 + (dim0 & 31);
        float ov[4];
#pragma unroll
        for (int j = 0; j < 4; ++j) { const float pr = __shfl_xor(xv[j], 8); const float c = tc[i0 + j], s = ts[i0 + j]; ov[j] = (l31 & 8) ? (xv[j] * c + pr * s) : (xv[j] * c - pr * s); }
        v2u o; o.x = pk2(ov[0], ov[1]); o.y = pk2(ov[2], ov[3]); *p = o;
    }
}
__device__ __forceinline__ gla::Io gla_io(const Ctx& C, int item, int dir) {
    gla::Io io; io.GR = WSP(float, WS_GR); io.GQK = WSP(bfu, WS_GQK); io.GV = WSP(bfu, WS_GV); io.wgk = dir ? C.wgk_b : C.wgk_f; io.bgk = dir ? C.bgk_b : C.bgk_f;
    io.ST = (float*)C.out + (size_t)(item * 2 + dir) * 32768; io.TOT = WSP(float, WS_TOT) + (item * 2 + dir) * 128;
    io.OF = WSP(bfu, WS_OF); io.UA = WSP(bfu, WS_UA); io.SG = WSP(bfu, WS_SGB); io.AQ = WSP(bfu, WS_AQ); io.gnorm = C.gla_norm; return io;
}
__device__ __forceinline__ void phase_gla_local(const Ctx& C) {
    for (int item = C.vcu; item < 256; item += C.G) { const int seg = item & 15, h = (item >> 4) & 3, b = item >> 6;
        for (int dir = 0; dir < 2; ++dir) { const gla::Io io = gla_io(C, item, dir); gla::pass<0>(C.lds, io, b, h, seg, dir, fresh_tid(C.wave_s)); } }
}
__device__ __forceinline__ void phase_gla_scan(const Ctx& C) {
    PHASE_IDS; float* ST = (float*)C.out; const float* TOT = WSP(float, WS_TOT);
    for (int idx = C.vcu * 512 + tid_; idx < 32 * 32768; idx += C.G * 512) { const int ch = idx >> 15, e = idx & 32767, dir = ch & 1, bh = ch >> 1;
        const int dk = 16 * (((e >> 8) & 15) >> 1) + 4 * ((e & 63) >> 4) + ((e >> 6) & 3);
        float loc[16], dec[16];
#pragma unroll
        for (int s = 0; s < 16; ++s) { const int seg = dir ? 15 - s : s, item = bh * 16 + seg; loc[s] = ST[(size_t)(item * 2 + dir) * 32768 + e]; dec[s] = TOT[(item * 2 + dir) * 128 + dk]; }
        float F = 0.f;
#pragma unroll
        for (int s = 0; s < 16; ++s) { const int seg = dir ? 15 - s : s, item = bh * 16 + seg; ST[(size_t)(item * 2 + dir) * 32768 + e] = F; F = __builtin_amdgcn_exp2f(1.4426950408889634f * dec[s]) * F + loc[s]; }
    }
}
__device__ __forceinline__ void phase_gla_out(const Ctx& C) {
    for (int item = C.vcu; item < 256; item += C.G) { const int seg = item & 15, h = (item >> 4) & 3, b = item >> 6;
        { const gla::Io io = gla_io(C, item, 0); gla::pass<1>(C.lds, io, b, h, seg, 0, fresh_tid(C.wave_s)); }
        VM_WAIT(); __syncthreads();
        { const gla::Io io = gla_io(C, item, 1); gla::pass<2>(C.lds, io, b, h, seg, 1, fresh_tid(C.wave_s)); } }
}
__device__ __forceinline__ void phase_final(const Ctx& C) {
    PHASE_IDS;
    const int gw = C.vcu * NWAVES + wave_, NGW = C.G * NWAVES; const float* rsq = WSP(float, WS_CTL) + CW_RSQ2;
    for (int m0 = gw; m0 < TOK; m0 += 2 * NGW) { float4 v[2][4];
#pragma unroll
        for (int q = 0; q < 2; ++q) { const int m = m0 + q * NGW; if (m < TOK) { const float4* xr = (const float4*)(C.out + (size_t)m * DM) + lane_;
#pragma unroll
            for (int j = 0; j < 4; ++j) v[q][j] = xr[64 * j]; } }
#pragma unroll
        for (int q = 0; q < 2; ++q) { const int m = m0 + q * NGW; if (m < TOK) { const float rstd = 1.0f / sqrtf(rsq[m] * (1.f / DM) + EPS); float4* xr = (float4*)(C.out + (size_t)m * DM) + lane_;
#pragma unroll
            for (int j = 0; j < 4; ++j) { float4 w = v[q][j]; const float4 g = *((const float4*)C.final_norm + lane_ + 64 * j); w.x *= rstd * g.x; w.y *= rstd * g.y; w.z *= rstd * g.z; w.w *= rstd * g.w; xr[64 * j] = w; } } }
    }
}
__device__ __forceinline__ void phase_attn(const Ctx& C) {
    const float* tc = WSP(float, WS_ROPE); const float* ts = tc + 2048; bfu* AQ = WSP(bfu, WS_AQ); const bfu* AKV = WSP(bfu, WS_AKV);
    for (int i = 0;; ++i) {
        int grp, uig;
        if (C.G == 256) { if (i >= 2) break; grp = C.vcu >> 5; uig = (C.vcu & 31) + 32 * i; }
        else { const int u = C.vcu + i * C.G; if (u >= 512) break; grp = u >> 6; uig = u & 63; }
        const int b = grp >> 1, kvh = grp & 1, hq = kvh * 4 + (uig >> 4), qb = uig & 15;
        const size_t r0 = (size_t)b * SEQ + qb * 256;
        attn::attn_unit(AQ + r0 * 1024 + hq * 128, AKV + (size_t)b * SEQ * 512 + kvh * 128, AKV + (size_t)b * SEQ * 512 + 256 + kvh * 128, ((DIAG == 4 || DIAG == 5) ? WSP(bfu, WS_OF) : AQ) + r0 * 1024 + hq * 128,
                        qb * 256, C.q_norm, tc, ts, SEQ, C.ldsg, fresh_tid(C.wave_s));
    }
}

constexpr int N_PHASES = 9;
struct Args { const float* in[16]; float* out; unsigned char* ws; int ph_lo, ph_hi; };
__global__ void __launch_bounds__(NWAVES * 64, 2) mk_fwd(Args args) {
    extern __shared__ __attribute__((aligned(16))) unsigned char lds[];
    Ctx C;
    C.lds = (LAS unsigned char*)lds; C.ldsg = (char*)lds;
    C.wave_s = __builtin_amdgcn_readfirstlane(threadIdx.x >> 6);
    C.G = gridDim.x; { const int bx = blockIdx.x; C.vcu = (C.G % 8 == 0) ? (bx % 8) * (C.G / 8) + bx / 8 : bx; }
    C.x = args.in[0]; C.mix_norm = args.in[1]; C.w_in = args.in[2]; C.wgk_f = args.in[3]; C.bgk_f = args.in[4]; C.wgk_b = args.in[5]; C.bgk_b = args.in[6]; C.gla_norm = args.in[7];
    C.q_norm = args.in[8]; C.k_norm = args.in[9]; C.b_gate = args.in[10]; C.w_o = args.in[11]; C.ffn_norm = args.in[12]; C.w_gu = args.in[13]; C.w_dn = args.in[14]; C.final_norm = args.in[15];
    C.out = args.out; C.ws = args.ws;
    volatile LAS unsigned* MISC = (volatile LAS unsigned*)(C.lds + MISC_OFF);
    for (int u = threadIdx.x; u < 512 / 4; u += NWAVES * 64) ((LAS unsigned*)(C.lds + LDS_BYTES - 512))[u] = 0u;
    __syncthreads();
    unsigned* ctl = (unsigned*)(C.ws + WS_CTL);
    XcdBarrier bar; bar.bar = ctl + CW_BAR; bar.x = 0; bar.st = nullptr;
    if (MK_N_LAUNCHES == 1) bar = xcd_barrier_post(ctl + CW_BAR, MISC + 8);
#define GRID_BAR() do { if (MK_N_LAUNCHES == 1) xcd_barrier(bar); } while (0)
    const int lo = args.ph_lo, hi = args.ph_hi;
#ifdef ONLY_PHASE
#define IN(k) ((k) == ONLY_PHASE && lo <= (k) && (k) < hi)
#else
#define IN(k) (lo <= (k) && (k) < hi)
#endif
#define BOTH(k) (IN(k) && IN((k) + 1))
#ifdef TIME_PHASE
    unsigned long long t_ph0 = __builtin_amdgcn_s_memrealtime();
#define TSPIN(k) do { const unsigned long long t1_ = __builtin_amdgcn_s_memrealtime(); if ((TIME_PHASE >> (k)) & 1) { const unsigned long long dt_ = t1_ - t_ph0; while (__builtin_amdgcn_s_memrealtime() - t1_ < dt_) __builtin_amdgcn_s_sleep(8); } __syncthreads(); t_ph0 = __builtin_amdgcn_s_memrealtime(); } while (0)
#else
#define TSPIN(k) do {} while (0)
#endif
    float* RSQ1 = (float*)ctl + CW_RSQ1; float* RSQ2 = (float*)ctl + CW_RSQ2;

    if (IN(0)) {
        phase_prologue(C); if (BOTH(0)) GRID_BAR(); TSPIN(0); }
    if (IN(1)) {
        pg8::Gemm g{(const pg8::bf16_t*)C.out, WSP(pg8::bf16_t, WS_WIN), TOK, NIN, DM}; pg8::StaticOrder S; S.init(TOK, NIN, C.G, (int)blockIdx.x);
        pg8::EpiIn E{WSP(pg8::bf16_t, WS_GQK), WSP(pg8::bf16_t, WS_GV), WSP(pg8::bf16_t, WS_UA), WSP(pg8::bf16_t, WS_SGB), WSP(pg8::bf16_t, WS_AQ), WSP(pg8::bf16_t, WS_AKV), WSP(float, WS_GR), C.b_gate};
        pg8::gemm_phase<pg8::EpiIn, pg8::StaticOrder, true, true>(C.lds, g, S, E, fresh_tid(C.wave_s));
        if (BOTH(1)) GRID_BAR(); TSPIN(1);
    }
    if (IN(2)) { phase_knorm(C); phase_gla_local(C); if (BOTH(2)) GRID_BAR(); TSPIN(2); }
    if (IN(3)) { phase_gla_scan(C); phase_attn(C); if (BOTH(3)) GRID_BAR(); TSPIN(3); }
    if (IN(4)) { phase_gla_out(C); if (BOTH(4)) GRID_BAR(); TSPIN(4); }
    if (IN(5)) {
        pg8::Gemm g{WSP(pg8::bf16_t, WS_AQ), WSP(pg8::bf16_t, WS_WO), TOK, DM, DM}; pg8::StaticOrder S; S.init(TOK, DM, C.G, (int)blockIdx.x);
        pg8::EpiRes E{C.x, C.out, WSP(pg8::bf16_t, WS_GQK), RSQ1};
        pg8::gemm_phase<pg8::EpiRes, pg8::StaticOrder, true, true>(C.lds, g, S, E, fresh_tid(C.wave_s));
        if (BOTH(5)) GRID_BAR(); TSPIN(5);
    }
    if (IN(6)) {
        pg8::Gemm g{WSP(pg8::bf16_t, WS_GQK), WSP(pg8::bf16_t, WS_WGU), TOK, 2 * DFF, DM}; pg8::StaticOrder S; S.init(TOK, 2 * DFF, C.G, (int)blockIdx.x);
        pg8::EpiGU E{WSP(pg8::bf16_t, WS_ACT), RSQ1};
        pg8::gemm_phase<pg8::EpiGU, pg8::StaticOrder, true, true>(C.lds, g, S, E, fresh_tid(C.wave_s));
        if (BOTH(6)) GRID_BAR(); TSPIN(6);
    }
    if (IN(7)) {
        pg8::Gemm g{WSP(pg8::bf16_t, WS_ACT), WSP(pg8::bf16_t, WS_WDN), TOK, DM, DFF}; pg8::StaticOrder S; S.init(TOK, DM, C.G, (int)blockIdx.x);
        pg8::EpiRes E{C.out, C.out, nullptr, RSQ2};
        pg8::gemm_phase<pg8::EpiRes, pg8::StaticOrder, true, true>(C.lds, g, S, E, fresh_tid(C.wave_s));
        if (BOTH(7)) GRID_BAR(); TSPIN(7);
    }
    if (IN(8)) { phase_final(C); }
#undef IN
#undef BOTH
}

extern "C" void kernel_launch(void* const* d_in, const int* in_sizes, int n_in, void* d_out, int out_size, void* d_ws, size_t ws_size, hipStream_t stream) {
    static int grid = 0;
    if (grid == 0) {
        if (n_in != 16 || in_sizes[0] != TOK * DM || out_size != TOK * DM || ws_size < WS_END) { fprintf(stderr, "kernel_launch: unexpected shapes (n_in %d, in0 %d, out %d, ws %zu)\n", n_in, n_in > 0 ? in_sizes[0] : -1, out_size, ws_size); grid = -1; return; }
        int dev = 0, cus = 0, per_cu = 0;
        if (hipGetDevice(&dev) != hipSuccess || hipDeviceGetAttribute(&cus, hipDeviceAttributeMultiprocessorCount, dev) != hipSuccess) { grid = -1; return; }
        if (hipFuncSetAttribute((const void*)mk_fwd, hipFuncAttributeMaxDynamicSharedMemorySize, LDS_BYTES) != hipSuccess) { fprintf(stderr, "kernel_launch: hipFuncSetAttribute failed\n"); grid = -1; return; }
        if (hipOccupancyMaxActiveBlocksPerMultiprocessor(&per_cu, (const void*)mk_fwd, NWAVES * 64, LDS_BYTES) != hipSuccess || per_cu < 1) { fprintf(stderr, "kernel_launch: occupancy query says %d blocks per CU\n", per_cu); }
        (void)hipGetLastError();
        grid = cus;
    }
    if (grid < 0) return;
    (void)hipMemsetAsync((char*)d_ws + WS_CTL, 0, CTL_ZERO_BYTES, stream);
    Args a{};
    for (int i = 0; i < 16; ++i) a.in[i] = (const float*)d_in[i];
    a.out = (float*)d_out; a.ws = (unsigned char*)d_ws;
    if (MK_N_LAUNCHES == 1) { a.ph_lo = 0; a.ph_hi = N_PHASES; hipLaunchKernelGGL(mk_fwd, dim3(grid), dim3(NWAVES * 64), LDS_BYTES, stream, a); }
    else for (int p = 0; p < N_PHASES; ++p) { a.ph_lo = p; a.ph_hi = p + 1; hipLaunchKernelGGL(mk_fwd, dim3(grid), dim3(NWAVES * 64), LDS_BYTES, stream, a); }
    const hipError_t le = hipPeekAtLastError();
    if (le != hipSuccess) fprintf(stderr, "kernel_launch: launch failed: %s\n", hipGetErrorName(le));
}
```
